# Optimizing an MI355X kernel written in HIP

```python
import jax, jax.numpy as jnp
from jax import lax
import numpy as np

D_MODEL = 1024
BATCH = 8
SEQ = 2048
DEPTH = 1
DEC_BATCH = 128
DEC_SEQ = 1
PAST_LEN = 16384
PAGE_SIZE = 128

HEAD_DIM = 64
RWKV_WIDTH = D_MODEL // 2
RWKV_HEADS = RWKV_WIDTH // HEAD_DIM
DECAY_LORA = 64
AAA_LORA = 64
GATE_LORA = 128
RWKV_PROJ = 3 * RWKV_WIDTH + DECAY_LORA + AAA_LORA + GATE_LORA
LRU_WIDTH = D_MODEL // 2
LRU_BLOCKS = 8
LRU_BLOCK = LRU_WIDTH // LRU_BLOCKS
LRU_CONV = 4
LRU_C = 8.0
IN_COLS = RWKV_PROJ + LRU_WIDTH + 2 * D_MODEL
D_FF = 2816
FFN_CONV = 3
NORM_EPS = 1e-6
LN_X_EPS = 64e-5

kernel_name = 'rwkv7_rglru_gated_hybrid_step'


def rmsnorm(x, g):
    x32 = x.astype(jnp.float32)
    y = x32 * lax.rsqrt(jnp.mean(x32 * x32, axis=-1, keepdims=True) + NORM_EPS)
    return (y * g.astype(jnp.float32)).astype(x.dtype)


def causal_dwconv(u, buf, w, b):
    width = w.shape[0]
    t = u.shape[1]
    full = jnp.concatenate([buf.astype(u.dtype), u], axis=1)
    y = b + sum(full[:, j:j + t] * w[j] for j in range(width))
    return y, full[:, t:]


def wkv7_scan(r, decay, k, v, aa, bb, s0):
    def step(s, inp):
        r_t, w_t, k_t, v_t, a_t, b_t = inp
        sa = jnp.einsum('bhvk,bhk->bhv', s, a_t)
        s = s * w_t[:, :, None, :] + sa[..., None] * b_t[:, :, None, :] + v_t[..., None] * k_t[:, :, None, :]
        return s, jnp.einsum('bhvk,bhk->bhv', s, r_t)
    xs = tuple(jnp.swapaxes(t.astype(jnp.float32), 0, 1) for t in (r, decay, k, v, aa, bb))
    s, ys = lax.scan(step, s0.astype(jnp.float32), xs)
    return jnp.swapaxes(ys, 0, 1), s


def rglru_scan(a, u, h0):
    def step(h, inp):
        a_t, u_t = inp
        h = a_t * h + u_t
        return h, h
    xs = (jnp.swapaxes(a, 0, 1), jnp.swapaxes(u, 0, 1))
    h, hs = lax.scan(step, h0.astype(jnp.float32), xs)
    return jnp.swapaxes(hs, 0, 1), h


def rwkv7_branch(p, shift_buf, s0, mu, w0, w_up, a0, a_up, g_up, k_k, k_a, r_k, lnx_w, lnx_b, w_out):
    b_, t_, _ = p.shape
    prev = jnp.concatenate([shift_buf.astype(p.dtype), p], axis=1)[:, :t_]
    new_shift = p[:, t_ - 1:]
    m = p + mu * (prev - p)
    cut = np.cumsum([RWKV_WIDTH, RWKV_WIDTH, RWKV_WIDTH, DECAY_LORA, AAA_LORA])
    r, k, v, wd, ad, gd = jnp.split(m, cut, axis=-1)
    w = -jax.nn.softplus(-(w0 + jnp.tanh(wd) @ w_up)) - 0.5
    decay = jnp.exp(-jnp.exp(w.astype(jnp.float32)))
    a = jax.nn.sigmoid(a0 + ad @ a_up)
    g = jax.nn.sigmoid(gd) @ g_up
    heads = lambda z: z.reshape(b_, t_, RWKV_HEADS, HEAD_DIM)
    kk = heads(k * k_k).astype(jnp.float32)
    kk = kk / jnp.maximum(jnp.sqrt(jnp.sum(kk * kk, axis=-1, keepdims=True)), 1e-12)
    k = k * (1.0 + (a - 1.0) * k_a)
    rh, kh, vh = heads(r), heads(k), heads(v)
    y, s = wkv7_scan(rh, heads(decay), kh, vh, -kk, kk * heads(a).astype(jnp.float32), s0)
    mean = jnp.mean(y, axis=-1, keepdims=True)
    var = jnp.mean(jnp.square(y - mean), axis=-1, keepdims=True)
    yn = ((y - mean) * lax.rsqrt(var + LN_X_EPS)).reshape(b_, t_, RWKV_WIDTH) * lnx_w + lnx_b
    bonus = (jnp.sum(rh * kh * r_k, axis=-1, keepdims=True) * vh).reshape(b_, t_, RWKV_WIDTH)
    out = ((yn.astype(p.dtype) + bonus) * g) @ w_out
    return out, new_shift, s


def rglru_branch(xb, conv_buf, h0, conv_w, conv_b, gx_w, gx_b, ga_w, ga_b, lam, w_out):
    b_, t_, _ = xb.shape
    xc, new_conv = causal_dwconv(xb, conv_buf, conv_w, conv_b)
    blk = xc.reshape(b_, t_, LRU_BLOCKS, LRU_BLOCK)
    gate_x = jax.nn.sigmoid(jnp.einsum('btni,nij->btnj', blk, gx_w).reshape(b_, t_, LRU_WIDTH) + gx_b)
    gate_a = jax.nn.sigmoid(jnp.einsum('btni,nij->btnj', blk, ga_w).reshape(b_, t_, LRU_WIDTH) + ga_b)
    log_a = -LRU_C * gate_a.astype(jnp.float32) * jax.nn.softplus(-lam.astype(jnp.float32))
    a = jnp.exp(log_a)
    u = jnp.sqrt(-jnp.expm1(2.0 * log_a)) * (gate_x * xc).astype(jnp.float32)
    hs, h = rglru_scan(a, u, h0)
    return hs.astype(xb.dtype) @ w_out, new_conv, h


def conv_ffn(h, buf, up, conv_w, conv_b, down):
    u, new_buf = causal_dwconv(h @ up, buf, conv_w, conv_b)
    gate, val = jnp.split(u, [D_FF], axis=-1)
    return (jax.nn.gelu(gate, approximate=True) * val) @ down, new_buf


def trunk_layer(x, shift_buf, wkv0, lru_buf, h0, ffn_buf,
                norm_pre_mix, norm_post_mix, norm_pre_ffn, norm_post_ffn, w_in,
                rwkv_mu, rwkv_w0, rwkv_w_up, rwkv_a0, rwkv_a_up, rwkv_g_up, rwkv_k_k, rwkv_k_a,
                rwkv_r_k, rwkv_lnx_w, rwkv_lnx_b, rwkv_w_out,
                lru_conv_w, lru_conv_b, lru_gx_w, lru_gx_b, lru_ga_w, lru_ga_b, lru_lambda, lru_w_out,
                w_o, ffn_up, ffn_conv_w, ffn_conv_b, ffn_down):
    xn = rmsnorm(x, norm_pre_mix)
    proj = xn @ w_in
    p_rwkv, xb, gates = jnp.split(proj, [RWKV_PROJ, RWKV_PROJ + LRU_WIDTH], axis=-1)
    oa, new_shift, wkv = rwkv7_branch(p_rwkv, shift_buf, wkv0, rwkv_mu, rwkv_w0, rwkv_w_up, rwkv_a0,
                                      rwkv_a_up, rwkv_g_up, rwkv_k_k, rwkv_k_a, rwkv_r_k,
                                      rwkv_lnx_w, rwkv_lnx_b, rwkv_w_out)
    ob, new_lru_buf, h = rglru_branch(xb, lru_buf, h0, lru_conv_w, lru_conv_b, lru_gx_w, lru_gx_b,
                                      lru_ga_w, lru_ga_b, lru_lambda, lru_w_out)
    ga, gb = jnp.split(jax.nn.sigmoid(gates), 2, axis=-1)
    mix = (ga * oa + gb * ob) @ w_o
    x = x + rmsnorm(mix, norm_post_mix)
    f, new_ffn_buf = conv_ffn(rmsnorm(x, norm_pre_ffn), ffn_buf, ffn_up, ffn_conv_w, ffn_conv_b, ffn_down)
    x = x + rmsnorm(f, norm_post_ffn)
    return x, (new_shift, wkv, new_lru_buf, h, new_ffn_buf)


def setup_inputs(seed: int = 0) -> dict:
    key = jax.random.key(seed)
    ks = iter(jax.random.split(key, 48))
    f32 = jnp.float32
    nrm = lambda shape, scale: jax.random.normal(next(ks), shape, f32) * scale
    L = DEPTH
    W = RWKV_WIDTH
    lam_u = jax.random.uniform(next(ks), (L, LRU_WIDTH), f32, minval=0.9, maxval=0.999)
    return {
        'x_prompt': nrm((BATCH, SEQ, D_MODEL), 1.0),
        'x_sample': nrm((DEC_BATCH, DEC_SEQ, D_MODEL), 1.0),
        'state_rwkv_shift': nrm((L, DEC_BATCH, 1, RWKV_PROJ), 1.0),
        'state_rwkv_wkv': nrm((L, DEC_BATCH, RWKV_HEADS, HEAD_DIM, HEAD_DIM), 0.5),
        'state_lru_conv': nrm((L, DEC_BATCH, LRU_CONV - 1, LRU_WIDTH), 1.0),
        'state_lru_h': nrm((L, DEC_BATCH, LRU_WIDTH), 0.5),
        'state_ffn_conv': nrm((L, DEC_BATCH, FFN_CONV - 1, 2 * D_FF), 1.0),
        'norm_pre_mix': 1.0 + nrm((L, D_MODEL), 0.02),
        'norm_post_mix': 1.0 + nrm((L, D_MODEL), 0.02),
        'norm_pre_ffn': 1.0 + nrm((L, D_MODEL), 0.02),
        'norm_post_ffn': 1.0 + nrm((L, D_MODEL), 0.02),
        'w_in': nrm((L, D_MODEL, IN_COLS), D_MODEL ** -0.5),
        'rwkv_mu': jax.random.uniform(next(ks), (L, RWKV_PROJ), f32),
        'rwkv_w0': jax.random.uniform(next(ks), (L, W), f32, minval=-6.0, maxval=0.0),
        'rwkv_w_up': nrm((L, DECAY_LORA, W), 0.1),
        'rwkv_a0': nrm((L, W), 0.1),
        'rwkv_a_up': nrm((L, AAA_LORA, W), 0.5 * AAA_LORA ** -0.5),
        'rwkv_g_up': nrm((L, GATE_LORA, W), GATE_LORA ** -0.5),
        'rwkv_k_k': 0.85 + nrm((L, W), 0.02),
        'rwkv_k_a': 1.0 + nrm((L, W), 0.02),
        'rwkv_r_k': nrm((L, RWKV_HEADS, HEAD_DIM), 0.1),
        'rwkv_lnx_w': 1.0 + nrm((L, W), 0.02),
        'rwkv_lnx_b': nrm((L, W), 0.02),
        'rwkv_w_out': nrm((L, W, D_MODEL), W ** -0.5),
        'lru_conv_w': nrm((L, LRU_CONV, LRU_WIDTH), LRU_CONV ** -0.5),
        'lru_conv_b': nrm((L, LRU_WIDTH), 0.02),
        'lru_gx_w': nrm((L, LRU_BLOCKS, LRU_BLOCK, LRU_BLOCK), LRU_BLOCK ** -0.5),
        'lru_gx_b': nrm((L, LRU_WIDTH), 0.02),
        'lru_ga_w': nrm((L, LRU_BLOCKS, LRU_BLOCK, LRU_BLOCK), LRU_BLOCK ** -0.5),
        'lru_ga_b': nrm((L, LRU_WIDTH), 0.02),
        'lru_lambda': jnp.log(lam_u) - jnp.log1p(-lam_u),
        'lru_w_out': nrm((L, LRU_WIDTH, D_MODEL), LRU_WIDTH ** -0.5),
        'w_o': nrm((L, D_MODEL, D_MODEL), D_MODEL ** -0.5),
        'ffn_up': nrm((L, D_MODEL, 2 * D_FF), D_MODEL ** -0.5),
        'ffn_conv_w': nrm((L, FFN_CONV, 2 * D_FF), FFN_CONV ** -0.5),
        'ffn_conv_b': nrm((L, 2 * D_FF), 0.02),
        'ffn_down': nrm((L, D_FF, D_MODEL), D_FF ** -0.5),
    }


def reference(x_prompt, x_sample, state_rwkv_shift, state_rwkv_wkv, state_lru_conv, state_lru_h, state_ffn_conv,
              norm_pre_mix, norm_post_mix, norm_pre_ffn, norm_post_ffn, w_in,
              rwkv_mu, rwkv_w0, rwkv_w_up, rwkv_a0, rwkv_a_up, rwkv_g_up, rwkv_k_k, rwkv_k_a,
              rwkv_r_k, rwkv_lnx_w, rwkv_lnx_b, rwkv_w_out,
              lru_conv_w, lru_conv_b, lru_gx_w, lru_gx_b, lru_ga_w, lru_ga_b, lru_lambda, lru_w_out,
              w_o, ffn_up, ffn_conv_w, ffn_conv_b, ffn_down):
    params = (norm_pre_mix, norm_post_mix, norm_pre_ffn, norm_post_ffn, w_in,
              rwkv_mu, rwkv_w0, rwkv_w_up, rwkv_a0, rwkv_a_up, rwkv_g_up, rwkv_k_k, rwkv_k_a,
              rwkv_r_k, rwkv_lnx_w, rwkv_lnx_b, rwkv_w_out,
              lru_conv_w, lru_conv_b, lru_gx_w, lru_gx_b, lru_ga_w, lru_ga_b, lru_lambda, lru_w_out,
              w_o, ffn_up, ffn_conv_w, ffn_conv_b, ffn_down)
    bp = x_prompt.shape[0]
    dt = x_prompt.dtype
    zero_states = (jnp.zeros((bp, 1, RWKV_PROJ), dt),
                   jnp.zeros((bp, RWKV_HEADS, HEAD_DIM, HEAD_DIM), jnp.float32),
                   jnp.zeros((bp, LRU_CONV - 1, LRU_WIDTH), dt),
                   jnp.zeros((bp, LRU_WIDTH), jnp.float32),
                   jnp.zeros((bp, FFN_CONV - 1, 2 * D_FF), dt))
    yp, ys = x_prompt, x_sample
    new_p, new_s = [], []
    for l in range(DEPTH):
        lp = [p[l] for p in params]
        yp, st_p = trunk_layer(yp, *zero_states, *lp)
        ys, st_s = trunk_layer(ys, state_rwkv_shift[l], state_rwkv_wkv[l], state_lru_conv[l],
                               state_lru_h[l], state_ffn_conv[l], *lp)
        new_p.append(st_p)
        new_s.append(st_s)
    stk = lambda lst, i: jnp.stack([s[i] for s in lst], axis=0)
    return (yp, ys,
            stk(new_p, 0), stk(new_p, 1), stk(new_p, 2), stk(new_p, 3), stk(new_p, 4),
            stk(new_s, 0), stk(new_s, 1), stk(new_s, 2), stk(new_s, 3), stk(new_s, 4))
```

```cpp
#include <hip/hip_runtime.h>
#include <hip/hip_cooperative_groups.h>
#include <cstdio>
namespace cg = cooperative_groups;

#ifndef ONE_LAUNCH
#define ONE_LAUNCH 1
#endif

#define LAS __attribute__((address_space(3)))
typedef unsigned short bf16_t;
typedef short bf16x8 __attribute__((ext_vector_type(8)));
typedef float f32x4 __attribute__((ext_vector_type(4)));
typedef unsigned u32x4 __attribute__((ext_vector_type(4)));
typedef unsigned u32x2 __attribute__((ext_vector_type(2)));

constexpr int MP = 16384, MT = 16512, MPAD = 16640;
constexpr int DM = 1024, RP = 1792, LW = 512, INC = 4352, DFF = 2816, DFF2 = 5632;
constexpr size_t O_YP = 0, O_YS = 16777216, O_PSHIFT = 16908288, O_PWKV = 16922624, O_PLCONV = 17184768, O_PLH = 17197056,
                 O_PFCONV = 17201152, O_SSHIFT = 17291264, O_SWKV = 17520640, O_SLCONV = 21714944, O_SLH = 21911552, O_SFCONV = 21977088;
constexpr size_t W_IN_T = 0, W_UP_T = 8912896, W_DN_T = 20447232, W_O_T = 26214400, W_A_T = 28311552, W_B_T = 29360128,
                 W_LRUG_T = 30408704, W_LORA_T = 31457280, ROWSS1 = 32243712, ROWSS2 = 32310272, CARRY_P = 32376832, CARRY_H = 32901120;
constexpr size_t BASE1 = 33554432;
constexpr size_t PROJ_O = BASE1;
constexpr size_t R2 = BASE1 + 144834560;
constexpr size_t SZ512 = (size_t)MPAD * 512 * 2;
constexpr size_t SZ1024 = (size_t)MPAD * 1024 * 2;
constexpr size_t XN_O = R2, KK_O = R2, E_O = R2 + SZ512, ASIG_O = R2 + 2 * SZ512, G_O = R2 + 3 * SZ512, Y_O = R2 + 4 * SZ512;
constexpr size_t MIXIN_O = R2, MIX_O = BASE1, HN_O = R2 + SZ1024, ACT_O = BASE1 + SZ1024, STASH_O = ACT_O + (size_t)MPAD * DFF * 2, F_O = BASE1;
constexpr size_t WS_NEED = R2 + 5 * SZ512;
static_assert(STASH_O + 260ull * 4 * DFF2 * 4 <= HN_O, "stash overlaps hn");
constexpr size_t LA_O = 0, XC_O = 8519680, LLA_O = XC_O + SZ512, LU_O = LLA_O + SZ512;
constexpr size_t ZA_O = XC_O, HS_O = LU_O;
static_assert(LU_O + SZ512 <= (size_t)MT * 1024 * 4, "d_out scratch too big");

constexpr int LDS_BYTES = 131072;

struct Params {
    const float* in[37];
    float* out;
    unsigned char* ws;
};
enum { I_XP = 0, I_XS, I_SSHIFT, I_SWKV, I_SLCONV, I_SLH, I_SFCONV, I_NPM, I_NPOM, I_NPF, I_NPOF, I_WIN, I_MU, I_W0, I_WUP, I_A0, I_AUP, I_GUP,
       I_KK, I_KA, I_RK, I_LNW, I_LNB, I_WOUT, I_LCW, I_LCB, I_GXW, I_GXB, I_GAW, I_GAB, I_LAM, I_LWOUT, I_WO, I_FUP, I_FCW, I_FCB, I_FDN };

__device__ __forceinline__ int TID() { int t = threadIdx.x; asm volatile("" : "+v"(t)); return t; }
__device__ __forceinline__ float bflo(unsigned u) { return __uint_as_float(u << 16); }
__device__ __forceinline__ float bfhi(unsigned u) { return __uint_as_float(u & 0xffff0000u); }
__device__ __forceinline__ float bf1(bf16_t b) { return __uint_as_float(((unsigned)b) << 16); }
__device__ __forceinline__ unsigned pk2(float lo, float hi) { unsigned r; asm volatile("v_cvt_pk_bf16_f32 %0, %1, %2" : "=v"(r) : "v"(lo), "v"(hi)); return r; }
__device__ __forceinline__ bf16_t f2bf(float f) { return (bf16_t)(pk2(f, 0.f) & 0xffffu); }
__device__ __forceinline__ void unpack8(const u32x4 u, float (&o)[8]) {
    o[0] = bflo(u.x); o[1] = bfhi(u.x); o[2] = bflo(u.y); o[3] = bfhi(u.y); o[4] = bflo(u.z); o[5] = bfhi(u.z); o[6] = bflo(u.w); o[7] = bfhi(u.w);
}
__device__ __forceinline__ u32x4 pack8(const float (&v)[8]) { u32x4 w; w.x = pk2(v[0], v[1]); w.y = pk2(v[2], v[3]); w.z = pk2(v[4], v[5]); w.w = pk2(v[6], v[7]); return w; }
__device__ __forceinline__ void ld8bf(const bf16_t* p, float (&o)[8]) { unpack8(*(const u32x4*)p, o); }
__device__ __forceinline__ void ld8f(const float* p, float (&o)[8]) { const f32x4 a = *(const f32x4*)p, b = *(const f32x4*)(p + 4); o[0] = a.x; o[1] = a.y; o[2] = a.z; o[3] = a.w; o[4] = b.x; o[5] = b.y; o[6] = b.z; o[7] = b.w; }
__device__ __forceinline__ void st8f(float* p, const float (&v)[8]) { *(f32x4*)p = (f32x4){v[0], v[1], v[2], v[3]}; *(f32x4*)(p + 4) = (f32x4){v[4], v[5], v[6], v[7]}; }
__device__ __forceinline__ float sigm(float x) { return 1.f / (1.f + __expf(-x)); }
__device__ __forceinline__ float tanh_(float x) { return 1.f - 2.f / (1.f + __expf(2.f * x)); }
__device__ __forceinline__ float gelu_t(float x) { return x * sigm(1.5957691216f * (x + 0.044715f * x * x * x)); }
__device__ __forceinline__ float wave_sum(float v) { for (int o = 32; o; o >>= 1) v += __shfl_xor(v, o); return v; }
template <int CTRL> __device__ __forceinline__ float dppf(float x) { return __int_as_float(__builtin_amdgcn_update_dpp(0, __float_as_int(x), CTRL, 0xF, 0xF, true)); }
__device__ __forceinline__ float row16_sum(float x) {
    x += dppf<0xB1>(x);
    x += dppf<0x4E>(x);
    x += dppf<0x141>(x);
    x += dppf<0x140>(x);
    return x;
}
#ifdef USE_BPERM
__device__ __forceinline__ float ror1(float x) { const int l = threadIdx.x & 63; return __shfl(x, (l & 48) | ((l - 1) & 15)); }
__device__ __forceinline__ float ror2(float x) { const int l = threadIdx.x & 63; return __shfl(x, (l & 48) | ((l - 2) & 15)); }
#else
__device__ __forceinline__ float ror1(float x) { return dppf<0x121>(x); }
__device__ __forceinline__ float ror2(float x) { return dppf<0x122>(x); }
#endif

__device__ __forceinline__ const bf16_t* wsb(const Params& P, size_t off) { return (const bf16_t*)(P.ws + off); }
__device__ __forceinline__ bf16_t* wsbw(const Params& P, size_t off) { return (bf16_t*)(P.ws + off); }
__device__ __forceinline__ bf16_t* outb(const Params& P, size_t off) { return (bf16_t*)((unsigned char*)P.out + off); }

__device__ __forceinline__ void shifted8(const Params& P, int row, int col, float (&m)[8]) {
    const bf16_t* proj = wsb(P, PROJ_O);
    float p[8], pv[8], mu[8];
    ld8bf(proj + (size_t)row * INC + col, p);
    if (row >= MP) ld8f(P.in[I_SSHIFT] + (size_t)(row - MP) * RP + col, pv);
    else if ((row & 2047) == 0) { for (int i = 0; i < 8; ++i) pv[i] = 0.f; }
    else ld8bf(proj + (size_t)(row - 1) * INC + col, pv);
    ld8f(P.in[I_MU] + col, mu);
#pragma unroll
    for (int i = 0; i < 8; ++i) m[i] = p[i] + mu[i] * (pv[i] - p[i]);
}
__device__ __forceinline__ float shifted1(const Params& P, int row, int col) {
    const bf16_t* proj = wsb(P, PROJ_O);
    const float p = bf1(proj[(size_t)row * INC + col]);
    float pv;
    if (row >= MP) pv = P.in[I_SSHIFT][(size_t)(row - MP) * RP + col];
    else if ((row & 2047) == 0) pv = 0.f;
    else pv = bf1(proj[(size_t)(row - 1) * INC + col]);
    return p + P.in[I_MU][col] * (pv - p);
}

constexpr int BM = 256, BK = 64, HALF = 128, HTB = HALF * BK * 2, NXCD = 8, WGM = 8;
__device__ __forceinline__ int lds_byte(int r, int c) { const int st = (r >> 4) * 2 + (c >> 5), rr = r & 15, cc = c & 31, ob = rr * 64 + cc * 2; return st * 1024 + (ob ^ (((ob >> 9) & 1) << 5)); }
__device__ __forceinline__ void stage_rc(int b, int& R, int& C) { const int st = b / 1024, sb = b % 1024, swz = sb ^ (((sb >> 9) & 1) << 5); R = (st >> 1) * 16 + swz / 64; C = (st & 1) * 32 + (swz % 64) / 2; }
__device__ __forceinline__ int perm32(int rho) { const int n = rho >> 4, i = rho & 15; return 8 * (i >> 2) + 4 * n + (i & 3); }

struct Unit { int pm, pn, kind; };
struct Sched {
    const char* A0; const char* B0; const char* A1; const char* B1;
    __device__ __forceinline__ const char* pa(int kind) const { return kind ? A1 : A0; }
    __device__ __forceinline__ const char* pb(int kind) const { return kind ? B1 : B0; }
    int nM, nN, nwg, G, c, sshift;
    size_t tstep;
    __device__ __forceinline__ void init(const void* a0, const void* b0, const void* a1, const void* b1, int M, int N, int K, int G_, int c_, int ss) {
        A0 = (const char*)a0; B0 = (const char*)b0; A1 = (const char*)a1; B1 = (const char*)b1;
        nM = M / BM; nN = N / BM; nwg = nM * nN; G = G_; c = c_; sshift = ss; tstep = (size_t)BM * K * 2;
    }
    __device__ __forceinline__ bool next(int i, Unit& u) const {
        const int j = i >> sshift; u.kind = i - (j << sshift);
        const long L = (long)j * G + c; if (L >= nwg) return false;
        int wgid = (int)L; { const int q = nwg / NXCD, r = nwg % NXCD, xcd = wgid % NXCD, off = wgid / NXCD; wgid = (xcd < r ? xcd * (q + 1) : r * (q + 1) + (xcd - r) * q) + off; }
        const int nig = WGM * nN, gid = wgid / nig, fm = gid * WGM, gsz = (nM - fm) < WGM ? (nM - fm) : WGM;
        u.pm = fm + ((wgid % nig) % gsz); u.pn = (wgid % nig) / gsz; return true;
    }
};

template <class Epi>
__device__ __forceinline__ void gemm_phase(LAS unsigned char* lds, const Sched& S, const int K, const Epi& E) {
    const int tid = TID(), wid = __builtin_amdgcn_readfirstlane(tid >> 6), lane = tid & 63, wr = wid >> 2, wc = wid & 3, fr = lane & 15, fq = lane >> 4;
    const int nt = K / BK;
    unsigned voffA[2], voffB[2];
#pragma unroll
    for (int i = 0; i < 2; ++i) { int R, C; stage_rc(tid * 16 + i * 8192, R, C); const int Rb = (R & ~31) + perm32(R & 31);
        voffA[i] = (unsigned)(R * K + C) * 2u; voffB[i] = (unsigned)(Rb * K + C) * 2u; }
    const size_t kstep = (size_t)(BK * 2);
    const size_t hstep = (size_t)HALF * K * 2;
    const unsigned ldsw = (unsigned)wid * 1024u;
    const int aoff = lds_byte(wr * 64 + fr, fq * 8), boff = lds_byte(wc * 32 + fr, fq * 8);
#define PG8_SA(b, h) (((b) * 2 + (h)) * HTB)
#define PG8_SB(b, h) ((4 + (b) * 2 + (h)) * HTB)
#define PG8_STAGE(bufoff, gbase, voff) do { _Pragma("unroll") for (int _i = 0; _i < 2; ++_i) \
        __builtin_amdgcn_global_load_lds((const unsigned*)((const char*)(gbase) + (voff)[_i]), (LAS unsigned*)(lds + (bufoff) + ldsw + _i * 8192), 16, 0, 0); } while (0)
#define PG8_LDA(dst, b, h) do { _Pragma("unroll") for (int m = 0; m < 4; ++m) _Pragma("unroll") for (int k = 0; k < 2; ++k) dst[m][k] = *(const LAS bf16x8*)(lds + PG8_SA(b, h) + aoff + m * 2048 + k * 1024); } while (0)
#define PG8_LDB(dst, b, h) do { _Pragma("unroll") for (int n = 0; n < 2; ++n) _Pragma("unroll") for (int k = 0; k < 2; ++k) dst[n][k] = *(const LAS bf16x8*)(lds + PG8_SB(b, h) + boff + n * 2048 + k * 1024); } while (0)
#define PG8_MMA(ai, bj, At, Bt) do { __builtin_amdgcn_s_setprio(1); _Pragma("unroll") for (int m = 0; m < 4; ++m) _Pragma("unroll") for (int n = 0; n < 2; ++n) _Pragma("unroll") for (int k = 0; k < 2; ++k) \
        acc[ai][bj][m][n] = __builtin_amdgcn_mfma_f32_16x16x32_bf16(Bt[n][k], At[m][k], acc[ai][bj][m][n], 0, 0, 0); __builtin_amdgcn_s_setprio(0); } while (0)
#define PG8_WAIT_V(n) asm volatile("s_waitcnt vmcnt(" #n ")" ::: "memory")
#define PG8_WAIT_L(n) asm volatile("s_waitcnt lgkmcnt(" #n ")" ::: "memory")
#define PG8_BAR __builtin_amdgcn_s_barrier()
#define PG8_SCHED __builtin_amdgcn_sched_barrier(0)
    Unit cur, nxt; int ui = 0;
    if (!S.next(0, cur)) return;
    f32x4 acc[2][2][4][2];
#pragma unroll
    for (int a = 0; a < 2; ++a)
#pragma unroll
        for (int b = 0; b < 2; ++b)
#pragma unroll
            for (int m = 0; m < 4; ++m)
#pragma unroll
                for (int n = 0; n < 2; ++n) acc[a][b][m][n] = (f32x4){0.f, 0.f, 0.f, 0.f};
    bf16x8 At[4][2], B0[2][2], B1[2][2];
    const char* cA = S.pa(cur.kind) + (size_t)cur.pm * S.tstep; const char* cB = S.pb(cur.kind) + (size_t)cur.pn * S.tstep;
    PG8_STAGE(PG8_SB(0, 0), cB, voffB); PG8_STAGE(PG8_SA(0, 0), cA, voffA); PG8_STAGE(PG8_SB(0, 1), cB + hstep, voffB); PG8_STAGE(PG8_SA(0, 1), cA + hstep, voffA);
    if (wr == 1) PG8_BAR;
    PG8_WAIT_V(4); PG8_BAR;
    PG8_STAGE(PG8_SB(1, 0), cB + kstep, voffB); PG8_STAGE(PG8_SA(1, 0), cA + kstep, voffA); PG8_STAGE(PG8_SB(1, 1), cB + hstep + kstep, voffB);
    PG8_WAIT_V(6); PG8_BAR;
    for (;;) {
        const bool has_next = S.next(ui + 1, nxt);
        const char* nA = has_next ? S.pa(nxt.kind) + (size_t)nxt.pm * S.tstep : cA; const char* nB = has_next ? S.pb(nxt.kind) + (size_t)nxt.pn * S.tstep : cB;
        for (int t = 0; t < nt; t += 2) {
            const bool last = (t == nt - 2);
            const char* a1 = cA + (size_t)(t + 1) * kstep;
            const char* a2 = last ? nA : cA + (size_t)(t + 2) * kstep; const char* b2 = last ? nB : cB + (size_t)(t + 2) * kstep;
            const char* a3 = a2 + kstep; const char* b3 = b2 + kstep;
            PG8_LDB(B0, 0, 0); PG8_SCHED; PG8_LDA(At, 0, 0); PG8_STAGE(PG8_SA(1, 1), a1 + hstep, voffA);
            PG8_WAIT_L(8); PG8_BAR; PG8_WAIT_L(0); PG8_MMA(0, 0, At, B0); PG8_BAR; PG8_SCHED;
            PG8_LDB(B1, 0, 1); PG8_STAGE(PG8_SB(0, 0), b2, voffB);
            PG8_BAR; PG8_WAIT_L(0); PG8_MMA(0, 1, At, B1); PG8_BAR;
            PG8_LDA(At, 0, 1); PG8_STAGE(PG8_SA(0, 0), a2, voffA);
            PG8_BAR; PG8_WAIT_L(0); PG8_MMA(1, 0, At, B0); PG8_BAR; PG8_SCHED;
            PG8_STAGE(PG8_SB(0, 1), b2 + hstep, voffB);
            PG8_WAIT_V(6); PG8_BAR; PG8_MMA(1, 1, At, B1); PG8_BAR;
            PG8_LDB(B0, 1, 0); PG8_SCHED; PG8_LDA(At, 1, 0); PG8_STAGE(PG8_SA(0, 1), a2 + hstep, voffA);
            PG8_WAIT_L(8); PG8_BAR; PG8_WAIT_L(0); PG8_MMA(0, 0, At, B0); PG8_BAR; PG8_SCHED;
            PG8_LDB(B1, 1, 1); PG8_STAGE(PG8_SB(1, 0), b3, voffB);
            PG8_BAR; PG8_WAIT_L(0); PG8_MMA(0, 1, At, B1); PG8_BAR;
            PG8_LDA(At, 1, 1); PG8_STAGE(PG8_SA(1, 0), a3, voffA);
            PG8_BAR; PG8_WAIT_L(0); PG8_MMA(1, 0, At, B0); PG8_BAR; PG8_SCHED;
            PG8_STAGE(PG8_SB(1, 1), b3 + hstep, voffB);
            PG8_WAIT_V(6); PG8_BAR; PG8_MMA(1, 1, At, B1); PG8_BAR;
        }
        const bool keep = E(acc, cur, wr, wc, fr, fq);
        if (!has_next) break;
        if (!keep) {
#pragma unroll
            for (int a = 0; a < 2; ++a)
#pragma unroll
                for (int b = 0; b < 2; ++b)
#pragma unroll
                    for (int m = 0; m < 4; ++m)
#pragma unroll
                        for (int n = 0; n < 2; ++n) acc[a][b][m][n] = (f32x4){0.f, 0.f, 0.f, 0.f};
        }
        cur = nxt; cA = nA; cB = nB; ++ui;
    }
    PG8_WAIT_V(0);
    if (wr == 0) PG8_BAR;
    PG8_BAR;
#undef PG8_SA
#undef PG8_SB
#undef PG8_STAGE
#undef PG8_LDA
#undef PG8_LDB
#undef PG8_MMA
#undef PG8_WAIT_V
#undef PG8_WAIT_L
#undef PG8_BAR
#undef PG8_SCHED
}

typedef f32x4 Acc[2][2][4][2];

struct EpiStore {
    bf16_t* O; int ldc; float* rowss;
    __device__ __forceinline__ bool operator()(Acc& acc, const Unit& u, int wr, int wc, int fr_, int fq_) const {
        int fr = fr_, fq = fq_; asm volatile("" : "+v"(fr), "+v"(fq));
        const int row0 = u.pm * BM + wr * 64 + fr, col0 = u.pn * BM + wc * 32 + 8 * fq;
#pragma unroll
        for (int ai = 0; ai < 2; ++ai)
#pragma unroll
            for (int m = 0; m < 4; ++m) {
                const int row = row0 + ai * HALF + m * 16;
                bf16_t* rowp = O + (size_t)row * ldc + col0;
                float ss = 0.f;
#pragma unroll
                for (int bj = 0; bj < 2; ++bj) {
                    const f32x4 v0 = acc[ai][bj][m][0], v1 = acc[ai][bj][m][1];
                    u32x4 w; w.x = pk2(v0[0], v0[1]); w.y = pk2(v0[2], v0[3]); w.z = pk2(v1[0], v1[1]); w.w = pk2(v1[2], v1[3]);
                    *(u32x4*)(rowp + bj * HALF) = w;
                    ss += v0[0] * v0[0] + v0[1] * v0[1] + v0[2] * v0[2] + v0[3] * v0[3] + v1[0] * v1[0] + v1[1] * v1[1] + v1[2] * v1[2] + v1[3] * v1[3];
                }
                if (rowss) { ss += __shfl_xor(ss, 16); ss += __shfl_xor(ss, 32); if (fq == 0) atomicAdd(rowss + row, ss); }
                __builtin_amdgcn_sched_barrier(0);
            }
        return false;
    }
};

struct EpiLora {
    const Params* P;
    __device__ __forceinline__ bool operator()(Acc& acc, const Unit& u, int wr, int wc, int fr_, int fq_) const {
        int fr = fr_, fq = fq_; asm volatile("" : "+v"(fr), "+v"(fq));
        const int sec = u.pn >> 1, cb = (u.pn & 1) * 256 + wc * 32 + 8 * fq, row0 = u.pm * BM + wr * 64 + fr;
        bf16_t* O = wsbw(*P, sec == 0 ? E_O : (sec == 1 ? ASIG_O : G_O));
        const float* bias = sec == 0 ? P->in[I_W0] : P->in[I_A0];
#pragma unroll
        for (int bj = 0; bj < 2; ++bj) {
            const int c = cb + bj * HALF;
            float bv[8];
            if (sec < 2) ld8f(bias + c, bv); else { for (int i = 0; i < 8; ++i) bv[i] = 0.f; }
#pragma unroll
            for (int ai = 0; ai < 2; ++ai)
#pragma unroll
                for (int m = 0; m < 4; ++m) {
                    const int row = row0 + ai * HALF + m * 16;
                    float v[8];
#pragma unroll
                    for (int i = 0; i < 8; ++i) v[i] = acc[ai][bj][m][i >> 2][i & 3] + bv[i];
                    if (sec == 0) { for (int i = 0; i < 8; ++i) v[i] = 0.6065306597f * sigm(v[i]); }
                    else if (sec == 1) { for (int i = 0; i < 8; ++i) v[i] = sigm(v[i]); }
                    *(u32x4*)(O + (size_t)row * 512 + c) = pack8(v);
                    __builtin_amdgcn_sched_barrier(0);
                }
        }
        return false;
    }
};

struct EpiLru {
    const Params* P;
    __device__ __forceinline__ bool operator()(Acc& acc, const Unit& u, int wr, int wc, int fr_, int fq_) const {
        int fr = fr_, fq = fq_; asm volatile("" : "+v"(fr), "+v"(fq));
        const int ch = u.pn * 128 + wc * 32 + 8 * fq, row0 = u.pm * BM + wr * 64 + fr;
        float gxb[8], gab[8], sp[8];
        ld8f(P->in[I_GXB] + ch, gxb); ld8f(P->in[I_GAB] + ch, gab); ld8f(P->in[I_LAM] + ch, sp);
#pragma unroll
        for (int i = 0; i < 8; ++i) sp[i] = -8.f * log1pf(__expf(-sp[i]));
        const bf16_t* XC = outb(*P, XC_O);
        bf16_t* LLA = outb(*P, LLA_O); bf16_t* LU = outb(*P, LU_O);
#pragma unroll
        for (int ai = 0; ai < 2; ++ai)
#pragma unroll
            for (int m = 0; m < 4; ++m) {
                const int row = row0 + ai * HALF + m * 16;
                float xc[8], la[8], uu[8];
                ld8bf(XC + (size_t)row * 512 + ch, xc);
#pragma unroll
                for (int i = 0; i < 8; ++i) {
                    const float gx = sigm(acc[ai][0][m][i >> 2][i & 3] + gxb[i]);
                    const float ga = sigm(acc[ai][1][m][i >> 2][i & 3] + gab[i]);
                    la[i] = ga * sp[i];
                    uu[i] = sqrtf(fmaxf(-expm1f(2.f * la[i]), 0.f)) * gx * xc[i];
                }
                if (row < MP) {
                    *(u32x4*)(LLA + (size_t)row * 512 + ch) = pack8(la);
                    *(u32x4*)(LU + (size_t)row * 512 + ch) = pack8(uu);
                } else if (row < MT) {
                    float h0[8], h[8];
                    ld8f(P->in[I_SLH] + (size_t)(row - MP) * 512 + ch, h0);
#pragma unroll
                    for (int i = 0; i < 8; ++i) h[i] = __expf(la[i]) * h0[i] + uu[i];
                    st8f(P->out + O_SLH + (size_t)(row - MP) * 512 + ch, h);
                    *(u32x4*)(LU + (size_t)row * 512 + ch) = pack8(h);
                } else {
                    *(u32x4*)(LU + (size_t)row * 512 + ch) = (u32x4){0u, 0u, 0u, 0u};
                }
                __builtin_amdgcn_sched_barrier(0);
            }
        return false;
    }
};

struct EpiMix {
    const Params* P;
    __device__ __forceinline__ bool operator()(Acc& acc, const Unit& u, int wr, int wc, int fr_, int fq_) const {
        int fr = fr_, fq = fq_; asm volatile("" : "+v"(fr), "+v"(fq));
        const int row0 = u.pm * BM + wr * 64 + fr, col0 = u.pn * BM + wc * 32 + 8 * fq;
        const bf16_t* proj = wsb(*P, PROJ_O);
        bf16_t* O = wsbw(*P, MIXIN_O);
#pragma unroll
        for (int ai = 0; ai < 2; ++ai)
#pragma unroll
            for (int m = 0; m < 4; ++m) {
                const int row = row0 + ai * HALF + m * 16;
#pragma unroll
                for (int bj = 0; bj < 2; ++bj) {
                    const int col = col0 + bj * HALF;
                    float gb[8];
                    ld8bf(proj + (size_t)row * INC + 3328 + col, gb);
                    if (u.kind == 0) {
                        float ga[8];
                        ld8bf(proj + (size_t)row * INC + 2304 + col, ga);
#pragma unroll
                        for (int i = 0; i < 8; ++i) acc[ai][bj][m][i >> 2][i & 3] *= (1.f + __expf(-gb[i])) / (1.f + __expf(-ga[i]));
                    } else {
                        float v[8];
#pragma unroll
                        for (int i = 0; i < 8; ++i) v[i] = acc[ai][bj][m][i >> 2][i & 3] * sigm(gb[i]);
                        *(u32x4*)(O + (size_t)row * 1024 + col) = pack8(v);
                    }
                    __builtin_amdgcn_sched_barrier(0);
                }
            }
        return u.kind == 0;
    }
};

struct EpiUp {
    const Params* P;
    __device__ __forceinline__ bool operator()(Acc& acc, const Unit& u, int wr, int wc, int fr_, int fq_) const {
        int fr = fr_, fq = fq_; asm volatile("" : "+v"(fr), "+v"(fq));
        const int cg0 = u.pn * 128 + wc * 32 + 8 * fq;
        const float* cw = P->in[I_FCW]; const float* cbias = P->in[I_FCB];
        bf16_t* ACT = wsbw(*P, ACT_O);
        float* STASH = (float*)(P->ws + STASH_O);
#pragma unroll
        for (int n = 0; n < 2; ++n) {
            const int cg = cg0 + 4 * n;
            const f32x4 wg0 = *(const f32x4*)(cw + cg), wg1 = *(const f32x4*)(cw + DFF2 + cg), wg2 = *(const f32x4*)(cw + 2 * DFF2 + cg), bg = *(const f32x4*)(cbias + cg);
            const f32x4 wv0 = *(const f32x4*)(cw + DFF + cg), wv1 = *(const f32x4*)(cw + DFF2 + DFF + cg), wv2 = *(const f32x4*)(cw + 2 * DFF2 + DFF + cg), bv = *(const f32x4*)(cbias + DFF + cg);
            if (u.pm < 64) {
#pragma unroll
                for (int ai = 0; ai < 2; ++ai)
#pragma unroll
                    for (int m = 0; m < 4; ++m) {
                        const int rr = m * 16 + fr, row = u.pm * BM + ai * HALF + wr * 64 + rr;
                        const f32x4 g0 = acc[ai][0][m][n], v0 = acc[ai][1][m][n];
                        const f32x4 gp = acc[ai][0][m > 0 ? m - 1 : 0][n], vp = acc[ai][1][m > 0 ? m - 1 : 0][n];
                        f32x4 g1, g2, v1, v2;
#pragma unroll
                        for (int j = 0; j < 4; ++j) {
                            g1[j] = ror1(fr == 15 ? gp[j] : g0[j]); g2[j] = ror2(fr >= 14 ? gp[j] : g0[j]);
                            v1[j] = ror1(fr == 15 ? vp[j] : v0[j]); v2[j] = ror2(fr >= 14 ? vp[j] : v0[j]);
                        }
                        if (rr >= 2) {
                            float a[4];
#pragma unroll
                            for (int j = 0; j < 4; ++j) {
                                const float ug = bg[j] + wg0[j] * g2[j] + wg1[j] * g1[j] + wg2[j] * g0[j];
                                const float uv = bv[j] + wv0[j] * v2[j] + wv1[j] * v1[j] + wv2[j] * v0[j];
                                a[j] = gelu_t(ug) * uv;
                            }
                            u32x2 w; w.x = pk2(a[0], a[1]); w.y = pk2(a[2], a[3]);
                            *(u32x2*)(ACT + (size_t)row * DFF + cg) = w;
                        }
                        if (rr < 2 || rr >= 62) {
                            float* sp = STASH + ((size_t)(row >> 6) * 4 + (rr < 2 ? rr : rr - 60)) * DFF2;
                            *(f32x4*)(sp + cg) = g0; *(f32x4*)(sp + DFF + cg) = v0;
                        }
                        __builtin_amdgcn_sched_barrier(0);
                    }
            } else {
#pragma unroll
                for (int m = 0; m < 4; ++m) {
                    const int b = wr * 64 + m * 16 + fr, row = MP + b;
                    const float* st = P->in[I_SFCONV] + (size_t)b * 2 * DFF2;
                    const f32x4 g0 = acc[0][0][m][n], v0 = acc[0][1][m][n];
                    const f32x4 g2 = *(const f32x4*)(st + cg), g1 = *(const f32x4*)(st + DFF2 + cg);
                    const f32x4 v2 = *(const f32x4*)(st + DFF + cg), v1 = *(const f32x4*)(st + DFF2 + DFF + cg);
                    float a[4];
#pragma unroll
                    for (int j = 0; j < 4; ++j) {
                        const float ug = bg[j] + wg0[j] * g2[j] + wg1[j] * g1[j] + wg2[j] * g0[j];
                        const float uv = bv[j] + wv0[j] * v2[j] + wv1[j] * v1[j] + wv2[j] * v0[j];
                        a[j] = gelu_t(ug) * uv;
                    }
                    u32x2 w; w.x = pk2(a[0], a[1]); w.y = pk2(a[2], a[3]);
                    *(u32x2*)(ACT + (size_t)row * DFF + cg) = w;
                    *(u32x2*)(ACT + (size_t)(row + HALF) * DFF + cg) = (u32x2){0u, 0u};
                    float* so = P->out + O_SFCONV + (size_t)b * 2 * DFF2;
                    *(f32x4*)(so + cg) = g1; *(f32x4*)(so + DFF + cg) = v1;
                    *(f32x4*)(so + DFF2 + cg) = g0; *(f32x4*)(so + DFF2 + DFF + cg) = v0;
                    __builtin_amdgcn_sched_barrier(0);
                }
            }
        }
        return false;
    }
};

__device__ void phase0(const Params& P, LAS unsigned char* ldsb, int bid, int nb) {
    LAS float* tile = (LAS float*)ldsb;
    const int tid = TID(), wid = tid >> 6, lane = tid & 63;
    const int nt_in = 16 * 68, nt_a = 8 * 16, nt_b = 8 * 16, nt_o = 16 * 16, nt_up = 16 * 88, nt_dn = 44 * 16;
    const int total = nt_in + nt_a + nt_b + nt_o + nt_up + nt_dn;
    for (int j = bid; j < total; j += nb) {
        int jj = j; const float* src; bf16_t* dst; int K, N, mode = 0;
        if (jj < nt_in) { src = P.in[I_WIN]; dst = wsbw(P, W_IN_T); K = 1024; N = 4352; }
        else if ((jj -= nt_in) < nt_a) { src = P.in[I_WOUT]; dst = wsbw(P, W_A_T); K = 512; N = 1024; }
        else if ((jj -= nt_a) < nt_b) { src = P.in[I_LWOUT]; dst = wsbw(P, W_B_T); K = 512; N = 1024; }
        else if ((jj -= nt_b) < nt_o) { src = P.in[I_WO]; dst = wsbw(P, W_O_T); K = 1024; N = 1024; }
        else if ((jj -= nt_o) < nt_up) { src = P.in[I_FUP]; dst = wsbw(P, W_UP_T); K = 1024; N = 5632; mode = 1; }
        else { jj -= nt_up; src = P.in[I_FDN]; dst = wsbw(P, W_DN_T); K = 2816; N = 1024; }
        const int ntn = N / 64, k0 = (jj / ntn) * 64, n0 = (jj % ntn) * 64;
        int drow0 = n0;
        if (mode == 1) { if (n0 < DFF) drow0 = (n0 / 128) * 256 + (n0 % 128); else { const int q = n0 - DFF; drow0 = (q / 128) * 256 + 128 + (q % 128); } }
#pragma unroll
        for (int i = 0; i < 8; ++i) { const int idx = tid + 512 * i, kk = idx >> 6, nn = idx & 63; tile[kk * 65 + nn] = src[(size_t)(k0 + kk) * N + n0 + nn]; }
        __syncthreads();
#pragma unroll
        for (int i = 0; i < 4; ++i) { const int idx = tid + 512 * i, nn = idx >> 5, kp = idx & 31;
            *(unsigned*)(dst + (size_t)(drow0 + nn) * K + k0 + 2 * kp) = pk2(tile[(2 * kp) * 65 + nn], tile[(2 * kp + 1) * 65 + nn]); }
        __syncthreads();
    }
    const int gtid = bid * 512 + tid, gth = nb * 512;
    { bf16_t* W = wsbw(P, W_LORA_T);
      for (int idx = gtid; idx < 1536 * 256; idx += gth) { const int n = idx >> 8, k = idx & 255; float v = 0.f;
          if (n < 512) { if (k < 64) v = P.in[I_WUP][k * 512 + n]; }
          else if (n < 1024) { if (k >= 64 && k < 128) v = P.in[I_AUP][(k - 64) * 512 + (n - 512)]; }
          else { if (k >= 128) v = P.in[I_GUP][(k - 128) * 512 + (n - 1024)]; }
          W[idx] = f2bf(v); } }
    { bf16_t* W = wsbw(P, W_LRUG_T);
      for (int idx = gtid; idx < 1024 * 512; idx += gth) { const int n = idx >> 9, k = idx & 511; const int pn = n >> 8, wi = n & 255, ch = pn * 128 + (wi & 127), blk = ch >> 6, jc = ch & 63;
          float v = 0.f; if ((k >> 6) == blk) v = (wi >= 128 ? P.in[I_GAW] : P.in[I_GXW])[blk * 4096 + (k & 63) * 64 + jc];
          W[idx] = f2bf(v); } }
    { float* r1 = (float*)(P.ws + ROWSS1); float* r2 = (float*)(P.ws + ROWSS2);
      for (int idx = gtid; idx < MPAD; idx += gth) { r1[idx] = 0.f; r2[idx] = 0.f; } }
    bf16_t* XN = wsbw(P, XN_O);
    for (int row = bid * 8 + wid; row < MPAD; row += nb * 8) {
        bf16_t* o = XN + (size_t)row * 1024;
        if (row >= MT) { for (int i = 0; i < 4; ++i) *(u32x2*)(o + lane * 4 + 256 * i) = (u32x2){0u, 0u}; continue; }
        const float* x = row < MP ? P.in[I_XP] + (size_t)row * 1024 : P.in[I_XS] + (size_t)(row - MP) * 1024;
        f32x4 v[4]; float ss = 0.f;
#pragma unroll
        for (int i = 0; i < 4; ++i) { v[i] = *(const f32x4*)(x + lane * 4 + 256 * i); ss += v[i].x * v[i].x + v[i].y * v[i].y + v[i].z * v[i].z + v[i].w * v[i].w; }
        ss = wave_sum(ss);
        const float sc = rsqrtf(ss * (1.f / 1024.f) + 1e-6f);
#pragma unroll
        for (int i = 0; i < 4; ++i) { const f32x4 g = *(const f32x4*)(P.in[I_NPM] + lane * 4 + 256 * i);
            u32x2 w; w.x = pk2(v[i].x * sc * g.x, v[i].y * sc * g.y); w.y = pk2(v[i].z * sc * g.z, v[i].w * sc * g.w); *(u32x2*)(o + lane * 4 + 256 * i) = w; }
    }
}

__device__ void phase_b0(const Params& P, int bid, int nb) {
    const int tid = TID(), wid = tid >> 6, lane = tid & 63;
    const bf16_t* proj = wsb(P, PROJ_O);
    bf16_t* LA = outb(P, LA_O); bf16_t* XC = outb(P, XC_O); bf16_t* KK = wsbw(P, KK_O);
    for (int row = bid * 8 + wid; row < MPAD; row += nb * 8) {
        if (row >= MT) {
            const u32x4 z = (u32x4){0u, 0u, 0u, 0u};
            if (lane < 32) *(u32x4*)(LA + (size_t)row * 256 + 8 * lane) = z;
            *(u32x4*)(XC + (size_t)row * 512 + 8 * lane) = z; *(u32x4*)(KK + (size_t)row * 512 + 8 * lane) = z;
            continue;
        }
        const bool sample = row >= MP; const int b = sample ? row - MP : row >> 11, t = sample ? 0 : (row & 2047);
        float m[8];
        { shifted8(P, row, 512 + 8 * lane, m);
          float kk[8], kkw[8]; ld8f(P.in[I_KK] + 8 * lane, kkw); float ss = 0.f;
#pragma unroll
          for (int i = 0; i < 8; ++i) { kk[i] = m[i] * kkw[i]; ss += kk[i] * kk[i]; }
          ss += __shfl_xor(ss, 1); ss += __shfl_xor(ss, 2); ss += __shfl_xor(ss, 4);
          const float inv = 1.f / fmaxf(sqrtf(ss), 1e-12f);
#pragma unroll
          for (int i = 0; i < 8; ++i) kk[i] *= inv;
          *(u32x4*)(KK + (size_t)row * 512 + 8 * lane) = pack8(kk); }
        if (lane < 32) {
            shifted8(P, row, 1536 + 8 * lane, m);
            if (lane < 8) { for (int i = 0; i < 8; ++i) m[i] = tanh_(m[i]); }
            else if (lane >= 16) { for (int i = 0; i < 8; ++i) m[i] = sigm(m[i]); }
            *(u32x4*)(LA + (size_t)row * 256 + 8 * lane) = pack8(m);
        }
        { const int c0 = 8 * lane; float x0[8], x1[8], x2[8], x3[8];
          ld8bf(proj + (size_t)row * INC + RP + c0, x3);
          if (sample) { const float* sb = P.in[I_SLCONV] + (size_t)b * 3 * 512 + c0; ld8f(sb, x0); ld8f(sb + 512, x1); ld8f(sb + 1024, x2); }
          else {
              if (t >= 1) ld8bf(proj + (size_t)(row - 1) * INC + RP + c0, x2); else { for (int i = 0; i < 8; ++i) x2[i] = 0.f; }
              if (t >= 2) ld8bf(proj + (size_t)(row - 2) * INC + RP + c0, x1); else { for (int i = 0; i < 8; ++i) x1[i] = 0.f; }
              if (t >= 3) ld8bf(proj + (size_t)(row - 3) * INC + RP + c0, x0); else { for (int i = 0; i < 8; ++i) x0[i] = 0.f; }
          }
          float w0[8], w1[8], w2[8], w3[8], cb[8], xc[8];
          ld8f(P.in[I_LCW] + c0, w0); ld8f(P.in[I_LCW] + 512 + c0, w1); ld8f(P.in[I_LCW] + 1024 + c0, w2); ld8f(P.in[I_LCW] + 1536 + c0, w3); ld8f(P.in[I_LCB] + c0, cb);
#pragma unroll
          for (int i = 0; i < 8; ++i) xc[i] = cb[i] + w0[i] * x0[i] + w1[i] * x1[i] + w2[i] * x2[i] + w3[i] * x3[i];
          *(u32x4*)(XC + (size_t)row * 512 + c0) = pack8(xc);
          if (sample) { float* o = P.out + O_SLCONV + (size_t)b * 3 * 512 + c0; st8f(o, x1); st8f(o + 512, x2); st8f(o + 1024, x3); }
          else if (t == 2047) { float* o = P.out + O_PLCONV + (size_t)b * 3 * 512 + c0; st8f(o, x1); st8f(o + 512, x2); st8f(o + 1024, x3); }
        }
        if (sample || t == 2047) {
            float* o = P.out + (sample ? O_SSHIFT : O_PSHIFT) + (size_t)b * RP;
            for (int ci = lane; ci < 224; ci += 64) { float p[8]; ld8bf(proj + (size_t)row * INC + 8 * ci, p); st8f(o + 8 * ci, p); }
        }
    }
}

__device__ void sample_wkv(const Params& P, int bid, int nb) {
    const int tid = TID(), wid = tid >> 6, lane = tid & 63, rowq = lane >> 4, kq = lane & 15;
    const bf16_t* E = wsb(P, E_O); const bf16_t* AS = wsb(P, ASIG_O); const bf16_t* KK = wsb(P, KK_O);
    bf16_t* Y = wsbw(P, Y_O);
    for (int it = bid * 8 + wid; it < 128 * 8; it += nb * 8) {
        const int b = it >> 3, h = it & 7, row = MP + b, hc = h * 64 + 4 * kq;
        float d[4], kp[4], na[4], nbv[4], r[4];
#pragma unroll
        for (int i = 0; i < 4; ++i) {
            const int c = hc + i;
            r[i] = shifted1(P, row, c);
            const float mk = shifted1(P, row, 512 + c);
            const float a = bf1(AS[(size_t)row * 512 + c]), kk = bf1(KK[(size_t)row * 512 + c]), e = bf1(E[(size_t)row * 512 + c]);
            d[i] = __expf(-e); kp[i] = mk * (1.f + (a - 1.f) * P.in[I_KA][c]); na[i] = -kk; nbv[i] = kk * a;
        }
        const float mv = shifted1(P, row, 1024 + h * 64 + lane);
        const float* S0 = P.in[I_SWKV] + (size_t)(b * 8 + h) * 4096;
        float* S1 = P.out + O_SWKV + (size_t)(b * 8 + h) * 4096;
        for (int i = 0; i < 16; ++i) {
            const int v = 4 * i + rowq;
            f32x4 s = *(const f32x4*)(S0 + v * 64 + 4 * kq);
            const float vv = __shfl(mv, v);
            float sa = s.x * na[0] + s.y * na[1] + s.z * na[2] + s.w * na[3];
            sa = row16_sum(sa);
            s.x = s.x * d[0] + sa * nbv[0] + vv * kp[0]; s.y = s.y * d[1] + sa * nbv[1] + vv * kp[1];
            s.z = s.z * d[2] + sa * nbv[2] + vv * kp[2]; s.w = s.w * d[3] + sa * nbv[3] + vv * kp[3];
            float y = s.x * r[0] + s.y * r[1] + s.z * r[2] + s.w * r[3];
            y = row16_sum(y);
            *(f32x4*)(S1 + v * 64 + 4 * kq) = s;
            if (kq == 0) Y[(size_t)row * 512 + h * 64 + v] = f2bf(y);
        }
    }
}

__device__ void lru_pass1(const Params& P, int bid, int nb) {
    const bf16_t* LLA = outb(P, LLA_O); const bf16_t* LU = outb(P, LU_O);
    float* CP = (float*)(P.ws + CARRY_P); float* CH = (float*)(P.ws + CARRY_H);
    for (int idx = bid * 512 + TID(); idx < 8 * 32 * 512; idx += nb * 512) {
        const int c = idx & 511, chunk = (idx >> 9) & 31, b = idx >> 14;
        const size_t base = ((size_t)b * 2048 + chunk * 64) * 512 + c;
        float h = 0.f, sp = 0.f;
#pragma unroll 16
        for (int t = 0; t < 64; ++t) { const float la = bf1(LLA[base + (size_t)t * 512]), u = bf1(LU[base + (size_t)t * 512]); h = __expf(la) * h + u; sp += la; }
        CP[idx] = sp; CH[idx] = h;
    }
}
__device__ void lru_pass2(const Params& P, int bid, int nb) {
    const bf16_t* LLA = outb(P, LLA_O); bf16_t* LU = outb(P, LU_O);
    const float* CP = (const float*)(P.ws + CARRY_P); const float* CH = (const float*)(P.ws + CARRY_H);
    for (int idx = bid * 512 + TID(); idx < 8 * 32 * 512; idx += nb * 512) {
        const int c = idx & 511, chunk = (idx >> 9) & 31, b = idx >> 14;
        float h = 0.f;
        for (int j = 0; j < chunk; ++j) { const int k = (b * 32 + j) * 512 + c; h = __expf(CP[k]) * h + CH[k]; }
        const size_t base = ((size_t)b * 2048 + chunk * 64) * 512 + c;
#pragma unroll 16
        for (int t = 0; t < 64; ++t) { const float la = bf1(LLA[base + (size_t)t * 512]), u = bf1(LU[base + (size_t)t * 512]); h = __expf(la) * h + u; LU[base + (size_t)t * 512] = f2bf(h); }
        if (chunk == 31) P.out[O_PLH + b * 512 + c] = h;
    }
}

constexpr int CHS = 32, REC = 336, NCH = 2048 / CHS;
__device__ void wkv_scan(const Params& P, int it, LAS float* lds) {
    const int tid = TID(), wid = __builtin_amdgcn_readfirstlane(tid >> 6), lane = tid & 63;
    const int xcd = it & 7, jj = it >> 3, s = jj & 3, bh = xcd + 8 * (jj >> 2), b = bh >> 3, h = bh & 7;
    LAS float* buf0 = lds; LAS float* buf1 = lds + CHS * REC; LAS float* yb = lds + 2 * CHS * REC;
    const size_t rowbase = (size_t)b * 2048;
    if (wid >= 4) {
        const int p = tid - 256, st = p >> 3, c8 = (p & 7) * 8, hc = h * 64 + c8;
        const bf16_t* proj = wsb(P, PROJ_O); const bf16_t* E = wsb(P, E_O); const bf16_t* AS = wsb(P, ASIG_O); const bf16_t* KK = wsb(P, KK_O);
        bf16_t* Y = wsbw(P, Y_O);
        float mur[8], muk[8], muv[8], ka[8];
        ld8f(P.in[I_MU] + hc, mur); ld8f(P.in[I_MU] + 512 + hc, muk); ld8f(P.in[I_MU] + 1024 + hc, muv); ld8f(P.in[I_KA] + hc, ka);
        u32x4 Lr, Lk, Lv, Lrp, Lkp, Lvp, Le, La, Lkk;
#define SC_LOAD(chunk) do { const int t_ = (chunk) * CHS + st; const size_t row_ = rowbase + t_; const bf16_t* pr_ = proj + row_ * INC + hc; \
        Lr = *(const u32x4*)pr_; Lk = *(const u32x4*)(pr_ + 512); Lv = *(const u32x4*)(pr_ + 1024); \
        if (t_ > 0) { Lrp = *(const u32x4*)(pr_ - INC); Lkp = *(const u32x4*)(pr_ - INC + 512); Lvp = *(const u32x4*)(pr_ - INC + 1024); } \
        else { Lrp = (u32x4){0u, 0u, 0u, 0u}; Lkp = Lrp; Lvp = Lrp; } \
        Le = *(const u32x4*)(E + row_ * 512 + hc); La = *(const u32x4*)(AS + row_ * 512 + hc); Lkk = *(const u32x4*)(KK + row_ * 512 + hc); } while (0)
#define SC_WRITE(buf) do { LAS float* rec_ = (buf) + st * REC + c8; float r_[8], rp_[8], k_[8], kpv_[8], v_[8], vp_[8], e_[8], a_[8], kk_[8]; \
        unpack8(Lr, r_); unpack8(Lrp, rp_); unpack8(Lk, k_); unpack8(Lkp, kpv_); unpack8(Lv, v_); unpack8(Lvp, vp_); unpack8(Le, e_); unpack8(La, a_); unpack8(Lkk, kk_); \
        float od_[8], ok_[8], ona_[8], onb_[8], or_[8], ov_[8]; \
        _Pragma("unroll") for (int i = 0; i < 8; ++i) { or_[i] = r_[i] + mur[i] * (rp_[i] - r_[i]); const float mk_ = k_[i] + muk[i] * (kpv_[i] - k_[i]); ov_[i] = v_[i] + muv[i] * (vp_[i] - v_[i]); \
            od_[i] = __expf(-e_[i]); ok_[i] = mk_ * (1.f + (a_[i] - 1.f) * ka[i]); ona_[i] = -kk_[i]; onb_[i] = kk_[i] * a_[i]; } \
        *(LAS f32x4*)(rec_) = (f32x4){od_[0], od_[1], od_[2], od_[3]}; *(LAS f32x4*)(rec_ + 4) = (f32x4){od_[4], od_[5], od_[6], od_[7]}; \
        *(LAS f32x4*)(rec_ + 64) = (f32x4){ok_[0], ok_[1], ok_[2], ok_[3]}; *(LAS f32x4*)(rec_ + 68) = (f32x4){ok_[4], ok_[5], ok_[6], ok_[7]}; \
        *(LAS f32x4*)(rec_ + 128) = (f32x4){ona_[0], ona_[1], ona_[2], ona_[3]}; *(LAS f32x4*)(rec_ + 132) = (f32x4){ona_[4], ona_[5], ona_[6], ona_[7]}; \
        *(LAS f32x4*)(rec_ + 192) = (f32x4){onb_[0], onb_[1], onb_[2], onb_[3]}; *(LAS f32x4*)(rec_ + 196) = (f32x4){onb_[4], onb_[5], onb_[6], onb_[7]}; \
        *(LAS f32x4*)(rec_ + 256) = (f32x4){or_[0], or_[1], or_[2], or_[3]}; *(LAS f32x4*)(rec_ + 260) = (f32x4){or_[4], or_[5], or_[6], or_[7]}; \
        if ((c8 >> 4) == s) { LAS float* vr_ = (buf) + st * REC + 320 + (c8 & 15); *(LAS f32x4*)(vr_) = (f32x4){ov_[0], ov_[1], ov_[2], ov_[3]}; *(LAS f32x4*)(vr_ + 4) = (f32x4){ov_[4], ov_[5], ov_[6], ov_[7]}; } } while (0)
#define SC_FLUSH(chunk) do { const LAS float* yy_ = yb + ((chunk) & 1) * CHS * 16 + st * 16 + 2 * (p & 7); \
        *(unsigned*)(Y + (rowbase + (chunk) * CHS + st) * 512 + h * 64 + 16 * s + 2 * (p & 7)) = pk2(yy_[0], yy_[1]); } while (0)
        SC_LOAD(0); SC_WRITE(buf0); SC_LOAD(1);
        __syncthreads();
        for (int c = 0; c < NCH; ++c) {
            if (c + 1 < NCH) { if (c & 1) SC_WRITE(buf0); else SC_WRITE(buf1); }
            if (c + 2 < NCH) SC_LOAD(c + 2);
            if (c > 0) SC_FLUSH(c - 1);
            __syncthreads();
        }
        SC_FLUSH(NCH - 1);
#undef SC_LOAD
#undef SC_WRITE
#undef SC_FLUSH
    } else {
        const int rowq = lane >> 4, kq = lane & 15, rloc = 4 * wid + rowq;
        f32x4 S = (f32x4){0.f, 0.f, 0.f, 0.f};
        __syncthreads();
        for (int c = 0; c < NCH; ++c) {
            const LAS float* bufc = (c & 1) ? buf1 : buf0; LAS float* ybc = yb + (c & 1) * CHS * 16;
#pragma unroll 4
            for (int st = 0; st < CHS; ++st) {
                const LAS float* rec = bufc + st * REC + 4 * kq;
                const f32x4 d = *(const LAS f32x4*)(rec), kp = *(const LAS f32x4*)(rec + 64), na = *(const LAS f32x4*)(rec + 128), nbv = *(const LAS f32x4*)(rec + 192), r = *(const LAS f32x4*)(rec + 256);
                const float vv = bufc[st * REC + 320 + rloc];
                float sa = S.x * na.x + S.y * na.y + S.z * na.z + S.w * na.w;
                sa = row16_sum(sa);
                S = S * d + sa * nbv + vv * kp;
                float y = S.x * r.x + S.y * r.y + S.z * r.z + S.w * r.w;
                y = row16_sum(y);
                if (kq == 0) ybc[st * 16 + rloc] = y;
            }
            __syncthreads();
        }
        *(f32x4*)(P.out + O_PWKV + ((size_t)(b * 8 + h) * 64 + 16 * s + rloc) * 64 + 4 * kq) = S;
    }
}

__device__ void phase_za(const Params& P, int bid, int nb) {
    const int tid = TID(), wid = tid >> 6, lane = tid & 63, c0 = 8 * lane;
    const bf16_t* AS = wsb(P, ASIG_O); const bf16_t* G = wsb(P, G_O); const bf16_t* Y = wsb(P, Y_O);
    bf16_t* ZA = outb(P, ZA_O);
    for (int row = bid * 8 + wid; row < MPAD; row += nb * 8) {
        if (row >= MT) { *(u32x4*)(ZA + (size_t)row * 512 + c0) = (u32x4){0u, 0u, 0u, 0u}; continue; }
        float r[8], k[8], v[8], a[8], y[8], g[8], ka[8], rk[8], lw[8], lb[8], za[8];
        shifted8(P, row, c0, r); shifted8(P, row, 512 + c0, k); shifted8(P, row, 1024 + c0, v);
        ld8bf(AS + (size_t)row * 512 + c0, a); ld8bf(Y + (size_t)row * 512 + c0, y); ld8bf(G + (size_t)row * 512 + c0, g);
        ld8f(P.in[I_KA] + c0, ka); ld8f(P.in[I_RK] + c0, rk); ld8f(P.in[I_LNW] + c0, lw); ld8f(P.in[I_LNB] + c0, lb);
        float sy = 0.f, sb = 0.f;
#pragma unroll
        for (int i = 0; i < 8; ++i) { sy += y[i]; sb += r[i] * k[i] * (1.f + (a[i] - 1.f) * ka[i]) * rk[i]; }
        sy += __shfl_xor(sy, 1); sy += __shfl_xor(sy, 2); sy += __shfl_xor(sy, 4);
        sb += __shfl_xor(sb, 1); sb += __shfl_xor(sb, 2); sb += __shfl_xor(sb, 4);
        const float mean = sy * (1.f / 64.f);
        float sv = 0.f;
#pragma unroll
        for (int i = 0; i < 8; ++i) { const float dd = y[i] - mean; sv += dd * dd; }
        sv += __shfl_xor(sv, 1); sv += __shfl_xor(sv, 2); sv += __shfl_xor(sv, 4);
        const float rs = rsqrtf(sv * (1.f / 64.f) + 64e-5f);
#pragma unroll
        for (int i = 0; i < 8; ++i) za[i] = ((y[i] - mean) * rs * lw[i] + lb[i] + sb * v[i]) * g[i];
        *(u32x4*)(ZA + (size_t)row * 512 + c0) = pack8(za);
    }
}

__device__ void phase_e(const Params& P, int bid, int nb) {
    const int tid = TID(), wid = tid >> 6, lane = tid & 63;
    const bf16_t* MIX = wsb(P, MIX_O); bf16_t* HN = wsbw(P, HN_O); const float* rss = (const float*)(P.ws + ROWSS1);
    for (int row = bid * 8 + wid; row < MPAD; row += nb * 8) {
        bf16_t* o = HN + (size_t)row * 1024;
        if (row >= MT) { for (int i = 0; i < 4; ++i) *(u32x2*)(o + lane * 4 + 256 * i) = (u32x2){0u, 0u}; continue; }
        const float* x = row < MP ? P.in[I_XP] + (size_t)row * 1024 : P.in[I_XS] + (size_t)(row - MP) * 1024;
        float* x1o = P.out + (size_t)row * 1024;
        const float sc = rsqrtf(rss[row] * (1.f / 1024.f) + 1e-6f);
        f32x4 v[4]; float ss = 0.f;
#pragma unroll
        for (int i = 0; i < 4; ++i) {
            const int c = lane * 4 + 256 * i;
            const f32x4 xv = *(const f32x4*)(x + c), g = *(const f32x4*)(P.in[I_NPOM] + c);
            const u32x2 mb = *(const u32x2*)(MIX + (size_t)row * 1024 + c);
            v[i].x = xv.x + bflo(mb.x) * sc * g.x; v[i].y = xv.y + bfhi(mb.x) * sc * g.y; v[i].z = xv.z + bflo(mb.y) * sc * g.z; v[i].w = xv.w + bfhi(mb.y) * sc * g.w;
            *(f32x4*)(x1o + c) = v[i];
            ss += v[i].x * v[i].x + v[i].y * v[i].y + v[i].z * v[i].z + v[i].w * v[i].w;
        }
        ss = wave_sum(ss);
        const float s2 = rsqrtf(ss * (1.f / 1024.f) + 1e-6f);
#pragma unroll
        for (int i = 0; i < 4; ++i) { const int c = lane * 4 + 256 * i; const f32x4 g = *(const f32x4*)(P.in[I_NPF] + c);
            u32x2 w; w.x = pk2(v[i].x * s2 * g.x, v[i].y * s2 * g.y); w.y = pk2(v[i].z * s2 * g.z, v[i].w * s2 * g.w); *(u32x2*)(o + c) = w; }
    }
}

__device__ void phase_f2(const Params& P, int bid, int nb) {
    const float* STASH = (const float*)(P.ws + STASH_O);
    bf16_t* ACT = wsbw(P, ACT_O);
    const float* cw = P.in[I_FCW]; const float* cbias = P.in[I_FCB];
    for (int idx = bid * 512 + TID(); idx < 256 * 2 * 704; idx += nb * 512) {
        const int c = (idx % 704) * 4, q = idx / 704, rr = q & 1, g = q >> 1, row = g * 64 + rr;
        const bool first = (g & 31) == 0;
        const float* sc = STASH + (size_t)g * 4 * DFF2; const float* spv = sc - 4 * DFF2;
        f32x4 a;
#pragma unroll
        for (int half = 0; half < 2; ++half) {
            const int cc = c + half * DFF;
            const f32x4 z = (f32x4){0.f, 0.f, 0.f, 0.f};
            f32x4 x0, x1, x2;
            if (rr == 0) { x0 = *(const f32x4*)(sc + cc); x1 = first ? z : *(const f32x4*)(spv + 3 * DFF2 + cc); x2 = first ? z : *(const f32x4*)(spv + 2 * DFF2 + cc); }
            else { x0 = *(const f32x4*)(sc + DFF2 + cc); x1 = *(const f32x4*)(sc + cc); x2 = first ? z : *(const f32x4*)(spv + 3 * DFF2 + cc); }
            const f32x4 w0 = *(const f32x4*)(cw + cc), w1 = *(const f32x4*)(cw + DFF2 + cc), w2 = *(const f32x4*)(cw + 2 * DFF2 + cc), bb = *(const f32x4*)(cbias + cc);
            const f32x4 uu = bb + w0 * x2 + w1 * x1 + w2 * x0;
            if (half == 0) { a.x = gelu_t(uu.x); a.y = gelu_t(uu.y); a.z = gelu_t(uu.z); a.w = gelu_t(uu.w); }
            else a = a * uu;
        }
        u32x2 w; w.x = pk2(a.x, a.y); w.y = pk2(a.z, a.w);
        *(u32x2*)(ACT + (size_t)row * DFF + c) = w;
    }
    for (int idx = bid * 512 + TID(); idx < 8 * 2 * 1408; idx += nb * 512) {
        const int c = (idx % 1408) * 4, q = idx / 1408, j = q & 1, b = q >> 1;
        *(f32x4*)(P.out + O_PFCONV + ((size_t)b * 2 + j) * DFF2 + c) = *(const f32x4*)(STASH + ((size_t)(b * 32 + 31) * 4 + 2 + j) * DFF2 + c);
    }
}

__device__ void phase_h(const Params& P, int bid, int nb) {
    const int tid = TID(), wid = tid >> 6, lane = tid & 63;
    const bf16_t* F = wsb(P, F_O); const float* rss = (const float*)(P.ws + ROWSS2);
    for (int row = bid * 8 + wid; row < MT; row += nb * 8) {
        float* xo = P.out + (size_t)row * 1024;
        const float sc = rsqrtf(rss[row] * (1.f / 1024.f) + 1e-6f);
#pragma unroll
        for (int i = 0; i < 4; ++i) {
            const int c = lane * 4 + 256 * i;
            f32x4 xv = *(const f32x4*)(xo + c); const f32x4 g = *(const f32x4*)(P.in[I_NPOF] + c);
            const u32x2 fb = *(const u32x2*)(F + (size_t)row * 1024 + c);
            xv.x += bflo(fb.x) * sc * g.x; xv.y += bfhi(fb.x) * sc * g.y; xv.z += bflo(fb.y) * sc * g.z; xv.w += bfhi(fb.y) * sc * g.w;
            *(f32x4*)(xo + c) = xv;
        }
    }
}

constexpr int NPHASE = 13;
__device__ __forceinline__ void run_phase(const Params& P, const int ph, LAS unsigned char* lds, int bid, int nb) {
    asm volatile("" : "+s"(bid), "+s"(nb));
    Sched S;
    switch (ph) {
    case 0: phase0(P, lds, bid, nb); break;
    case 1: { S.init(P.ws + XN_O, P.ws + W_IN_T, nullptr, nullptr, MPAD, INC, 1024, nb, bid, 0); EpiStore E{wsbw(P, PROJ_O), INC, nullptr}; gemm_phase(lds, S, 1024, E); } break;
    case 2: phase_b0(P, bid, nb); break;
    case 3: { S.init((unsigned char*)P.out + LA_O, P.ws + W_LORA_T, nullptr, nullptr, MPAD, 1536, 256, nb, bid, 0); EpiLora E{&P}; gemm_phase(lds, S, 256, E);
              S.init((unsigned char*)P.out + XC_O, P.ws + W_LRUG_T, nullptr, nullptr, MPAD, 1024, 512, nb, (bid + nb / 2) % nb, 0); EpiLru E2{&P}; gemm_phase(lds, S, 512, E2); } break;
    case 4: sample_wkv(P, bid, nb); lru_pass1(P, bid, nb);
            for (int it = bid; it < 256; it += nb) { wkv_scan(P, it, (LAS float*)lds); __syncthreads(); } break;
    case 5: lru_pass2(P, bid, nb); phase_za(P, bid, nb); break;
    case 6: { S.init((unsigned char*)P.out + ZA_O, P.ws + W_A_T, (unsigned char*)P.out + HS_O, P.ws + W_B_T, MPAD, 1024, 512, nb, bid, 1); EpiMix E{&P}; gemm_phase(lds, S, 512, E); } break;
    case 7: { S.init(P.ws + MIXIN_O, P.ws + W_O_T, nullptr, nullptr, MPAD, 1024, 1024, nb, bid, 0); EpiStore E{wsbw(P, MIX_O), 1024, (float*)(P.ws + ROWSS1)}; gemm_phase(lds, S, 1024, E); } break;
    case 8: phase_e(P, bid, nb); break;
    case 9: { S.init(P.ws + HN_O, P.ws + W_UP_T, nullptr, nullptr, MPAD, DFF2, 1024, nb, bid, 0); EpiUp E{&P}; gemm_phase(lds, S, 1024, E); } break;
    case 10: phase_f2(P, bid, nb); break;
    case 11: { S.init(P.ws + ACT_O, P.ws + W_DN_T, nullptr, nullptr, MPAD, 1024, DFF, nb, bid, 0); EpiStore E{wsbw(P, F_O), 1024, (float*)(P.ws + ROWSS2)}; gemm_phase(lds, S, DFF, E); } break;
    case 12: phase_h(P, bid, nb); break;
    }
}

template <int PH0, int PH1>
__global__ void __launch_bounds__(512, 2) mega(Params P) {
    extern __shared__ __attribute__((aligned(16))) unsigned char shm[];
    LAS unsigned char* lds = (LAS unsigned char*)shm;
    cg::grid_group grid = cg::this_grid();
#define MK_PHASE(ph) do { if constexpr ((ph) >= PH0 && (ph) < PH1) { \
          \
        const __attribute__((address_space(4))) Params* kp = (const __attribute__((address_space(4))) Params*)__builtin_amdgcn_kernarg_segment_ptr(); \
        asm volatile("" : "+s"(kp)); \
        run_phase(*(const Params*)kp, (ph), lds, blockIdx.x, gridDim.x); \
        if constexpr ((ph) + 1 < PH1) grid.sync(); } } while (0)
    MK_PHASE(0); MK_PHASE(1); MK_PHASE(2); MK_PHASE(3); MK_PHASE(4); MK_PHASE(5); MK_PHASE(6);
    MK_PHASE(7); MK_PHASE(8); MK_PHASE(9); MK_PHASE(10); MK_PHASE(11); MK_PHASE(12);
#undef MK_PHASE
}

template <int PH0, int PH1>
static void launch_range(const Params& p, hipStream_t stream) {
    static int grid_blocks = 0;
    const void* fn = (const void*)mega<PH0, PH1>;
    if (!grid_blocks) {
        (void)hipFuncSetAttribute(fn, hipFuncAttributeMaxDynamicSharedMemorySize, LDS_BYTES);
        int dev = 0, cus = 0, per_cu = 0;
        (void)hipGetDevice(&dev);
        (void)hipDeviceGetAttribute(&cus, hipDeviceAttributeMultiprocessorCount, dev);
        (void)hipOccupancyMaxActiveBlocksPerMultiprocessor(&per_cu, mega<PH0, PH1>, 512, LDS_BYTES);
        if (per_cu != 1) fprintf(stderr, "note: occupancy query says %d blocks/CU; using 1\n", per_cu);
        grid_blocks = cus;
        if (per_cu < 1) grid_blocks = 0;
    }
    if (!grid_blocks) { fprintf(stderr, "kernel not launchable\n"); return; }
    Params pl = p;
    void* args[] = {&pl};
    hipError_t e = hipLaunchCooperativeKernel(fn, dim3(grid_blocks), dim3(512), args, LDS_BYTES, stream);
    if (e != hipSuccess) fprintf(stderr, "cooperative launch failed: %s (grid %d)\n", hipGetErrorString(e), grid_blocks);
}

extern "C" void kernel_launch(void* const* d_in, const int* in_sizes, int n_in, void* d_out, int out_size, void* d_ws, size_t ws_size, hipStream_t stream) {
    if (ws_size < WS_NEED) { fprintf(stderr, "workspace too small: %zu < %zu\n", ws_size, (size_t)WS_NEED); return; }
    Params p{};
    for (int i = 0; i < 37; ++i) p.in[i] = (const float*)d_in[i];
    p.out = (float*)d_out; p.ws = (unsigned char*)d_ws;
#if ONE_LAUNCH
    launch_range<0, NPHASE>(p, stream);
#else
    launch_range<0, 1>(p, stream); launch_range<1, 2>(p, stream); launch_range<2, 3>(p, stream); launch_range<3, 4>(p, stream);
    launch_range<4, 5>(p, stream); launch_range<5, 6>(p, stream); launch_range<6, 7>(p, stream); launch_range<7, 8>(p, stream);
    launch_range<8, 9>(p, stream); launch_range<9, 10>(p, stream); launch_range<10, 11>(p, stream); launch_range<11, 12>(p, stream);
    launch_range<12, 13>(p, stream);
#endif
}
```

```cpp
#include <hip/hip_runtime.h>
#include <hip/hip_cooperative_groups.h>
#include <cstdio>
namespace cg = cooperative_groups;

#ifndef ONE_LAUNCH
#define ONE_LAUNCH 1
#endif

#define LAS __attribute__((address_space(3)))
typedef unsigned short bf16_t;
typedef short bf16x8 __attribute__((ext_vector_type(8)));
typedef float f32x4 __attribute__((ext_vector_type(4)));
typedef unsigned u32x4 __attribute__((ext_vector_type(4)));
typedef unsigned u32x2 __attribute__((ext_vector_type(2)));

constexpr int MP = 16384, MT = 16512, MPAD = 16640;
constexpr int DM = 1024, RP = 1792, LW = 512, INC = 4352, DFF = 2816, DFF2 = 5632;
constexpr size_t O_YP = 0, O_YS = 16777216, O_PSHIFT = 16908288, O_PWKV = 16922624, O_PLCONV = 17184768, O_PLH = 17197056,
                 O_PFCONV = 17201152, O_SSHIFT = 17291264, O_SWKV = 17520640, O_SLCONV = 21714944, O_SLH = 21911552, O_SFCONV = 21977088;
constexpr size_t W_IN_T = 0, W_UP_T = 8912896, W_DN_T = 20447232, W_O_T = 26214400, W_A_T = 28311552, W_B_T = 29360128,
                 W_LRUG_T = 30408704, W_LORA_T = 31457280, ROWSS1 = 32243712, ROWSS2 = 32310272;
constexpr size_t BASE1 = 33554432;
constexpr size_t PROJ_O = BASE1;
constexpr size_t R2 = BASE1 + 144834560;
constexpr size_t SZ512 = (size_t)MPAD * 512 * 2;
constexpr size_t SZ1024 = (size_t)MPAD * 1024 * 2;
constexpr size_t XN_O = R2, KK_O = R2, E_O = R2 + SZ512, ASIG_O = R2 + 2 * SZ512, G_O = R2 + 3 * SZ512, Y_O = R2 + 4 * SZ512;
constexpr size_t MIXIN_O = R2, MIX_O = BASE1, HN_O = R2 + SZ1024, ACT_O = BASE1 + SZ1024, STASH_O = ACT_O + (size_t)MPAD * DFF * 2, F_O = R2;
constexpr size_t CARRY_P = R2 + 5 * SZ512, CARRY_H = CARRY_P + 1048576, TS_O = CARRY_H + 1048576;
constexpr size_t BAR_O = TS_O + 1024;
constexpr size_t MIXS_O = BAR_O + 16384, FS_O = MIXS_O + 524288;
constexpr size_t BON_O = FS_O + 524288;
constexpr size_t WS_NEED = BON_O + (size_t)MT * 8 * 4;
static_assert(WS_NEED <= 268435456ull, "ws too big");
constexpr size_t SUP_O = STASH_O + 260ull * 4 * DFF2 * 4;
static_assert(SUP_O + 128ull * DFF2 * 4 <= HN_O, "stash overlaps hn");
constexpr size_t LA_O = 0, XC_O = 8519680, LLA_O = XC_O + SZ512, LU_O = LLA_O + SZ512;
constexpr size_t ZA_O = XC_O, HS_O = LU_O;
static_assert(LU_O + SZ512 <= (size_t)MT * 1024 * 4, "d_out scratch too big");

constexpr int LDS_BYTES = 131072 + 64;

struct Params {
    const float* in[37];
    float* out;
    unsigned char* ws;
};
enum { I_XP = 0, I_XS, I_SSHIFT, I_SWKV, I_SLCONV, I_SLH, I_SFCONV, I_NPM, I_NPOM, I_NPF, I_NPOF, I_WIN, I_MU, I_W0, I_WUP, I_A0, I_AUP, I_GUP,
       I_KK, I_KA, I_RK, I_LNW, I_LNB, I_WOUT, I_LCW, I_LCB, I_GXW, I_GXB, I_GAW, I_GAB, I_LAM, I_LWOUT, I_WO, I_FUP, I_FCW, I_FCB, I_FDN };

__device__ __forceinline__ int TID() { int t = threadIdx.x; asm volatile("" : "+v"(t)); return t; }
__device__ __forceinline__ float bflo(unsigned u) { return __uint_as_float(u << 16); }
__device__ __forceinline__ float bfhi(unsigned u) { return __uint_as_float(u & 0xffff0000u); }
__device__ __forceinline__ float bf1(bf16_t b) { return __uint_as_float(((unsigned)b) << 16); }
__device__ __forceinline__ unsigned pk2(float lo, float hi) { unsigned r; asm volatile("v_cvt_pk_bf16_f32 %0, %1, %2" : "=v"(r) : "v"(lo), "v"(hi)); return r; }
__device__ __forceinline__ bf16_t f2bf(float f) { return (bf16_t)(pk2(f, 0.f) & 0xffffu); }
__device__ __forceinline__ void unpack8(const u32x4 u, float (&o)[8]) {
    o[0] = bflo(u.x); o[1] = bfhi(u.x); o[2] = bflo(u.y); o[3] = bfhi(u.y); o[4] = bflo(u.z); o[5] = bfhi(u.z); o[6] = bflo(u.w); o[7] = bfhi(u.w);
}
__device__ __forceinline__ u32x4 pack8(const float (&v)[8]) { u32x4 w; w.x = pk2(v[0], v[1]); w.y = pk2(v[2], v[3]); w.z = pk2(v[4], v[5]); w.w = pk2(v[6], v[7]); return w; }
__device__ __forceinline__ void ld8bf(const bf16_t* p, float (&o)[8]) { unpack8(*(const u32x4*)p, o); }
__device__ __forceinline__ void ld8bf_nt(const bf16_t* p, float (&o)[8]) { unpack8(__builtin_nontemporal_load((const u32x4*)p), o); }
__device__ __forceinline__ void ld8f(const float* p, float (&o)[8]) { const f32x4 a = *(const f32x4*)p, b = *(const f32x4*)(p + 4); o[0] = a.x; o[1] = a.y; o[2] = a.z; o[3] = a.w; o[4] = b.x; o[5] = b.y; o[6] = b.z; o[7] = b.w; }
__device__ __forceinline__ void st8f(float* p, const float (&v)[8]) { *(f32x4*)p = (f32x4){v[0], v[1], v[2], v[3]}; *(f32x4*)(p + 4) = (f32x4){v[4], v[5], v[6], v[7]}; }
__device__ __forceinline__ float rcp_(float x) { return __builtin_amdgcn_rcpf(x); }
__device__ __forceinline__ float sigm(float x) { return rcp_(1.f + __expf(-x)); }
__device__ __forceinline__ float tanh_(float x) { return 1.f - 2.f * rcp_(1.f + __expf(2.f * x)); }
__device__ __forceinline__ float fma_s(float a, float b, float c) { float r; asm("v_fma_f32 %0, %1, %2, %3" : "=v"(r) : "v"(a), "v"(b), "v"(c)); return r; }
__device__ __forceinline__ float gelu_t(float x) { const float p = fmaf(x * x, -0.10294324f, -2.30220819f);
    return x * rcp_(1.f + __builtin_amdgcn_exp2f(p * x)); }
__device__ __forceinline__ float wave_sum(float v) { for (int o = 32; o; o >>= 1) v += __shfl_xor(v, o); return v; }
template <int CTRL> __device__ __forceinline__ float dppf(float x) { return __int_as_float(__builtin_amdgcn_update_dpp(0, __float_as_int(x), CTRL, 0xF, 0xF, true)); }
__device__ __forceinline__ float row16_sum(float x) {
    x += dppf<0xB1>(x);
    x += dppf<0x4E>(x);
    x += dppf<0x141>(x);
    x += dppf<0x140>(x);
    return x;
}
#ifdef USE_BPERM
__device__ __forceinline__ float ror1(float x) { const int l = threadIdx.x & 63; return __shfl(x, (l & 48) | ((l - 1) & 15)); }
__device__ __forceinline__ float ror2(float x) { const int l = threadIdx.x & 63; return __shfl(x, (l & 48) | ((l - 2) & 15)); }
#else
__device__ __forceinline__ float ror1(float x) { return dppf<0x121>(x); }
__device__ __forceinline__ float ror2(float x) { return dppf<0x122>(x); }
#endif

__device__ __forceinline__ const bf16_t* wsb(const Params& P, size_t off) { return (const bf16_t*)(P.ws + off); }
__device__ __forceinline__ bf16_t* wsbw(const Params& P, size_t off) { return (bf16_t*)(P.ws + off); }
__device__ __forceinline__ bf16_t* outb(const Params& P, size_t off) { return (bf16_t*)((unsigned char*)P.out + off); }

__device__ __forceinline__ void shifted8(const Params& P, int row, int col, float (&m)[8]) {
    const bf16_t* proj = wsb(P, PROJ_O);
    float p[8], pv[8], mu[8];
    ld8bf(proj + (size_t)row * INC + col, p);
    if (row >= MP) ld8f(P.in[I_SSHIFT] + (size_t)(row - MP) * RP + col, pv);
    else if ((row & 2047) == 0) { for (int i = 0; i < 8; ++i) pv[i] = 0.f; }
    else ld8bf(proj + (size_t)(row - 1) * INC + col, pv);
    ld8f(P.in[I_MU] + col, mu);
#pragma unroll
    for (int i = 0; i < 8; ++i) m[i] = p[i] + mu[i] * (pv[i] - p[i]);
}
__device__ __forceinline__ float shifted1(const Params& P, int row, int col) {
    const bf16_t* proj = wsb(P, PROJ_O);
    const float p = bf1(proj[(size_t)row * INC + col]);
    float pv;
    if (row >= MP) pv = P.in[I_SSHIFT][(size_t)(row - MP) * RP + col];
    else if ((row & 2047) == 0) pv = 0.f;
    else pv = bf1(proj[(size_t)(row - 1) * INC + col]);
    return p + P.in[I_MU][col] * (pv - p);
}

#ifndef PQ
#define PQ 600
#endif
#ifdef PROBE_TS
#define MARK(P_, i_) do { if (blockIdx.x == 0 && threadIdx.x == 0) ((unsigned long long*)((P_).ws + TS_O))[(i_)] = __builtin_amdgcn_s_memrealtime(); } while (0)
#else
#define MARK(P_, i_) do { } while (0)
#endif
constexpr int BM = 256, BK = 64, HALF = 128, HTB = HALF * BK * 2, NXCD = 8, WGM = 8;
__device__ __forceinline__ int lds_byte(int r, int c) { const int st = (r >> 4) * 2 + (c >> 5), rr = r & 15, cc = c & 31, ob = rr * 64 + cc * 2; return st * 1024 + (ob ^ (((ob >> 9) & 1) << 5)); }
__device__ __forceinline__ void stage_rc(int b, int& R, int& C) { const int st = b / 1024, sb = b % 1024, swz = sb ^ (((sb >> 9) & 1) << 5); R = (st >> 1) * 16 + swz / 64; C = (st & 1) * 32 + (swz % 64) / 2; }
__device__ __forceinline__ int perm32(int rho) { const int n = rho >> 4, i = rho & 15; return 8 * (i >> 2) + 4 * n + (i & 3); }

struct Unit { int pm, pn, kind; };
struct Sched {
    const char* A0; const char* B0; const char* A1; const char* B1;
    __device__ __forceinline__ const char* pa(int kind) const { return kind ? A1 : A0; }
    __device__ __forceinline__ const char* pb(int kind) const { return kind ? B1 : B0; }
    unsigned long long* tsacc;
    int nM, nN, nwg, G, c, sshift;
    size_t tstep;
    __device__ __forceinline__ void init(const void* a0, const void* b0, const void* a1, const void* b1, int M, int N, int K, int G_, int c_, int ss) {
        A0 = (const char*)a0; B0 = (const char*)b0; A1 = (const char*)a1; B1 = (const char*)b1;
        nM = M / BM; nN = N / BM; nwg = nM * nN; G = G_; c = c_; sshift = ss; tstep = (size_t)BM * K * 2; tsacc = nullptr;
    }
    __device__ __forceinline__ bool next(int i, Unit& u) const {
        const int j = i >> sshift; u.kind = i - (j << sshift);
        const long L = (long)j * G + c; if (L >= nwg) return false;
        int wgid = (int)L; { const int q = nwg / NXCD, r = nwg % NXCD, xcd = wgid % NXCD, off = wgid / NXCD; wgid = (xcd < r ? xcd * (q + 1) : r * (q + 1) + (xcd - r) * q) + off; }
        const int nig = WGM * nN, gid = wgid / nig, fm = gid * WGM, gsz = (nM - fm) < WGM ? (nM - fm) : WGM;
        u.pm = fm + ((wgid % nig) % gsz); u.pn = (wgid % nig) / gsz; return true;
    }
};

template <class Epi>
__device__ __forceinline__ void gemm_phase(LAS unsigned char* lds, const Sched& S, const int K, const Epi& E) {
    const int tid = TID(), wid = __builtin_amdgcn_readfirstlane(tid >> 6), lane = tid & 63, wr = wid >> 2, wc = wid & 3, fr = lane & 15, fq = lane >> 4;
    const int nt = K / BK;
    unsigned voffA[2], voffB[2];
#pragma unroll
    for (int i = 0; i < 2; ++i) { int R, C; stage_rc(tid * 16 + i * 8192, R, C); const int Rb = (R & ~31) + perm32(R & 31);
        voffA[i] = (unsigned)(R * K + C) * 2u; voffB[i] = (unsigned)(Rb * K + C) * 2u; }
    const size_t kstep = (size_t)(BK * 2);
    const size_t hstep = (size_t)HALF * K * 2;
    const unsigned ldsw = (unsigned)wid * 1024u;
    const int aoff = lds_byte(wr * 64 + fr, fq * 8), boff = lds_byte(wc * 32 + fr, fq * 8);
#define PG8_SA(b, h) (((b) * 2 + (h)) * HTB)
#define PG8_SB(b, h) ((4 + (b) * 2 + (h)) * HTB)
#define PG8_STAGE(bufoff, gbase, voff) do { _Pragma("unroll") for (int _i = 0; _i < 2; ++_i) \
        __builtin_amdgcn_global_load_lds((const unsigned*)((const char*)(gbase) + (voff)[_i]), (LAS unsigned*)(lds + (bufoff) + ldsw + _i * 8192), 16, 0, 0); } while (0)
#define PG8_LDA(dst, b, h) do { _Pragma("unroll") for (int m = 0; m < 4; ++m) _Pragma("unroll") for (int k = 0; k < 2; ++k) dst[m][k] = *(const LAS bf16x8*)(lds + PG8_SA(b, h) + aoff + m * 2048 + k * 1024); } while (0)
#define PG8_LDB(dst, b, h) do { _Pragma("unroll") for (int n = 0; n < 2; ++n) _Pragma("unroll") for (int k = 0; k < 2; ++k) dst[n][k] = *(const LAS bf16x8*)(lds + PG8_SB(b, h) + boff + n * 2048 + k * 1024); } while (0)
#define PG8_MMA(ai, bj, At, Bt) do { __builtin_amdgcn_s_setprio(1); _Pragma("unroll") for (int m = 0; m < 4; ++m) _Pragma("unroll") for (int n = 0; n < 2; ++n) _Pragma("unroll") for (int k = 0; k < 2; ++k) \
        acc[ai][bj][m][n] = __builtin_amdgcn_mfma_f32_16x16x32_bf16(Bt[n][k], At[m][k], acc[ai][bj][m][n], 0, 0, 0); __builtin_amdgcn_s_setprio(0); } while (0)
#define PG8_WAIT_V(n) asm volatile("s_waitcnt vmcnt(" #n ")" ::: "memory")
#define PG8_WAIT_L(n) asm volatile("s_waitcnt lgkmcnt(" #n ")" ::: "memory")
#define PG8_BAR __builtin_amdgcn_s_barrier()
#define PG8_SCHED __builtin_amdgcn_sched_barrier(0)
    Unit cur, nxt; int ui = 0;
    if (!S.next(0, cur)) return;
#ifdef STAGGER_TICKS
    { const unsigned long long t0_ = __builtin_amdgcn_s_memrealtime(), dl_ = (unsigned long long)((S.c >> 3) & 3) * STAGGER_TICKS;
      while (__builtin_amdgcn_s_memrealtime() - t0_ < dl_) __builtin_amdgcn_s_sleep(4); }
#endif
    f32x4 acc[2][2][4][2];
#pragma unroll
    for (int a = 0; a < 2; ++a)
#pragma unroll
        for (int b = 0; b < 2; ++b)
#pragma unroll
            for (int m = 0; m < 4; ++m)
#pragma unroll
                for (int n = 0; n < 2; ++n) acc[a][b][m][n] = (f32x4){0.f, 0.f, 0.f, 0.f};
    bf16x8 At[4][2], B0[2][2], B1[2][2];
    const char* cA = S.pa(cur.kind) + (size_t)cur.pm * S.tstep; const char* cB = S.pb(cur.kind) + (size_t)cur.pn * S.tstep;
    PG8_STAGE(PG8_SB(0, 0), cB, voffB); PG8_STAGE(PG8_SA(0, 0), cA, voffA); PG8_STAGE(PG8_SB(0, 1), cB + hstep, voffB); PG8_STAGE(PG8_SA(0, 1), cA + hstep, voffA);
    if (wr == 1) PG8_BAR;
    PG8_WAIT_V(4); PG8_BAR;
    PG8_STAGE(PG8_SB(1, 0), cB + kstep, voffB); PG8_STAGE(PG8_SA(1, 0), cA + kstep, voffA); PG8_STAGE(PG8_SB(1, 1), cB + hstep + kstep, voffB);
    PG8_WAIT_V(6); PG8_BAR;
    for (;;) {
        const bool has_next = S.next(ui + 1, nxt);
        const char* nA = has_next ? S.pa(nxt.kind) + (size_t)nxt.pm * S.tstep : cA; const char* nB = has_next ? S.pb(nxt.kind) + (size_t)nxt.pn * S.tstep : cB;
        for (int t = 0; t < nt; t += 2) {
            const bool last = (t == nt - 2);
            const char* a1 = cA + (size_t)(t + 1) * kstep;
            const char* a2 = last ? nA : cA + (size_t)(t + 2) * kstep; const char* b2 = last ? nB : cB + (size_t)(t + 2) * kstep;
            const char* a3 = a2 + kstep; const char* b3 = b2 + kstep;
            PG8_LDB(B0, 0, 0); PG8_SCHED; PG8_LDA(At, 0, 0); PG8_STAGE(PG8_SA(1, 1), a1 + hstep, voffA);
            PG8_WAIT_L(8); PG8_BAR; PG8_WAIT_L(0); PG8_MMA(0, 0, At, B0); PG8_BAR; PG8_SCHED;
            PG8_LDB(B1, 0, 1); PG8_STAGE(PG8_SB(0, 0), b2, voffB);
            PG8_BAR; PG8_WAIT_L(0); PG8_MMA(0, 1, At, B1); PG8_BAR;
            PG8_LDA(At, 0, 1); PG8_STAGE(PG8_SA(0, 0), a2, voffA);
            PG8_BAR; PG8_WAIT_L(0); PG8_MMA(1, 0, At, B0); PG8_BAR; PG8_SCHED;
            PG8_STAGE(PG8_SB(0, 1), b2 + hstep, voffB);
            PG8_WAIT_V(6); PG8_BAR; PG8_MMA(1, 1, At, B1); PG8_BAR;
            PG8_LDB(B0, 1, 0); PG8_SCHED; PG8_LDA(At, 1, 0); PG8_STAGE(PG8_SA(0, 1), a2 + hstep, voffA);
            PG8_WAIT_L(8); PG8_BAR; PG8_WAIT_L(0); PG8_MMA(0, 0, At, B0); PG8_BAR; PG8_SCHED;
            PG8_LDB(B1, 1, 1); PG8_STAGE(PG8_SB(1, 0), b3, voffB);
            PG8_BAR; PG8_WAIT_L(0); PG8_MMA(0, 1, At, B1); PG8_BAR;
            PG8_LDA(At, 1, 1); PG8_STAGE(PG8_SA(1, 0), a3, voffA);
            PG8_BAR; PG8_WAIT_L(0); PG8_MMA(1, 0, At, B0); PG8_BAR; PG8_SCHED;
            PG8_STAGE(PG8_SB(1, 1), b3 + hstep, voffB);
            PG8_WAIT_V(6); PG8_BAR; PG8_MMA(1, 1, At, B1); PG8_BAR;
        }
#ifdef PROBE_EPI
        unsigned long long te0_ = 0; if (S.tsacc && blockIdx.x == 0 && threadIdx.x == 0) te0_ = __builtin_amdgcn_s_memrealtime();
#endif
        const bool keep = E(acc, cur, wr, wc, fr, fq);
#ifdef PROBE_EPI
        if (S.tsacc && blockIdx.x == 0 && threadIdx.x == 0) { asm volatile("s_waitcnt vmcnt(0)" ::: "memory"); *S.tsacc += __builtin_amdgcn_s_memrealtime() - te0_; }
#endif
        if (!has_next) break;
        if (!keep) {
#pragma unroll
            for (int a = 0; a < 2; ++a)
#pragma unroll
                for (int b = 0; b < 2; ++b)
#pragma unroll
                    for (int m = 0; m < 4; ++m)
#pragma unroll
                        for (int n = 0; n < 2; ++n) acc[a][b][m][n] = (f32x4){0.f, 0.f, 0.f, 0.f};
        }
        cur = nxt; cA = nA; cB = nB; ++ui;
    }
    PG8_WAIT_V(0);
    if (wr == 0) PG8_BAR;
    PG8_BAR;
#undef PG8_SA
#undef PG8_SB
#undef PG8_STAGE
#undef PG8_LDA
#undef PG8_LDB
#undef PG8_MMA
#undef PG8_WAIT_V
#undef PG8_WAIT_L
#undef PG8_BAR
#undef PG8_SCHED
}

typedef f32x4 Acc[2][2][4][2];

struct EpiStore {
    bf16_t* O; int ldc; float* rowss;
    __device__ __forceinline__ bool operator()(Acc& acc, const Unit& u, int wr, int wc, int fr_, int fq_) const {
        int fr = fr_, fq = fq_; asm volatile("" : "+v"(fr), "+v"(fq));
        const int row0 = u.pm * BM + wr * 64 + fr, col0 = u.pn * BM + wc * 32 + 8 * fq;
#pragma unroll
        for (int ai = 0; ai < 2; ++ai)
#pragma unroll
            for (int m = 0; m < 4; ++m) {
                const int row = row0 + ai * HALF + m * 16;
                bf16_t* rowp = O + (size_t)row * ldc + col0;
                float ss = 0.f;
#pragma unroll
                for (int bj = 0; bj < 2; ++bj) {
                    const f32x4 v0 = acc[ai][bj][m][0], v1 = acc[ai][bj][m][1];
                    u32x4 w; w.x = pk2(v0[0], v0[1]); w.y = pk2(v0[2], v0[3]); w.z = pk2(v1[0], v1[1]); w.w = pk2(v1[2], v1[3]);
                    *(u32x4*)(rowp + bj * HALF) = w;
                    ss += v0[0] * v0[0] + v0[1] * v0[1] + v0[2] * v0[2] + v0[3] * v0[3] + v1[0] * v1[0] + v1[1] * v1[1] + v1[2] * v1[2] + v1[3] * v1[3];
                }
                if (rowss) { ss += __shfl_xor(ss, 16); ss += __shfl_xor(ss, 32); if (fq == 0) atomicAdd(rowss + row, ss); }
                __builtin_amdgcn_sched_barrier(0);
            }
        return false;
    }
};

struct EpiLora {
    const Params* P;
    __device__ __forceinline__ bool operator()(Acc& acc, const Unit& u, int wr, int wc, int fr_, int fq_) const {
        int fr = fr_, fq = fq_; asm volatile("" : "+v"(fr), "+v"(fq));
        const int sec = u.pn >> 1, cb = (u.pn & 1) * 256 + wc * 32 + 8 * fq, row0 = u.pm * BM + wr * 64 + fr;
        bf16_t* O = wsbw(*P, sec == 0 ? E_O : (sec == 1 ? ASIG_O : G_O));
        const float* bias = sec == 0 ? P->in[I_W0] : P->in[I_A0];
#pragma unroll
        for (int bj = 0; bj < 2; ++bj) {
            const int c = cb + bj * HALF;
            float bv[8];
            if (sec < 2) ld8f(bias + c, bv); else { for (int i = 0; i < 8; ++i) bv[i] = 0.f; }
#pragma unroll
            for (int ai = 0; ai < 2; ++ai)
#pragma unroll
                for (int m = 0; m < 4; ++m) {
                    int row = row0 + ai * HALF + m * 16; asm volatile("" : "+v"(row));
                    float v[8];
#pragma unroll
                    for (int i = 0; i < 8; ++i) v[i] = acc[ai][bj][m][i >> 2][i & 3] + bv[i];
                    if (sec == 0) { for (int i = 0; i < 8; ++i) v[i] = 0.6065306597f * sigm(v[i]); }
                    else if (sec == 1) { for (int i = 0; i < 8; ++i) v[i] = sigm(v[i]); }
                    *(u32x4*)(O + (size_t)row * 512 + c) = pack8(v);
                    __builtin_amdgcn_sched_barrier(0);
                }
        }
        return false;
    }
};

struct EpiLru {
    const Params* P;
    __device__ __forceinline__ bool operator()(Acc& acc, const Unit& u, int wr, int wc, int fr_, int fq_) const {
        int fr = fr_, fq = fq_; asm volatile("" : "+v"(fr), "+v"(fq));
        const int ch = u.pn * 128 + wc * 32 + 8 * fq, row0 = u.pm * BM + wr * 64 + fr;
        float gxb[8], gab[8], sp[8];
        ld8f(P->in[I_GXB] + ch, gxb); ld8f(P->in[I_GAB] + ch, gab); ld8f(P->in[I_LAM] + ch, sp);
#pragma unroll
        for (int i = 0; i < 8; ++i) sp[i] = -8.f * log1pf(__expf(-sp[i]));
        const bf16_t* XC = outb(*P, XC_O);
        bf16_t* LLA = outb(*P, LLA_O); bf16_t* LU = outb(*P, LU_O);
#pragma unroll
        for (int ai = 0; ai < 2; ++ai) {
            u32x4 xcr[4];
#pragma unroll
            for (int m = 0; m < 4; ++m) xcr[m] = *(const u32x4*)(XC + (size_t)(row0 + ai * HALF + m * 16) * 512 + ch);
#pragma unroll
            for (int m = 0; m < 4; ++m) {
                int row = row0 + ai * HALF + m * 16; asm volatile("" : "+v"(row));
                float xc[8], la[8], uu[8];
                unpack8(xcr[m], xc);
#pragma unroll
                for (int i = 0; i < 8; ++i) {
                    const float gx = sigm(acc[ai][0][m][i >> 2][i & 3] + gxb[i]);
                    const float ga = sigm(acc[ai][1][m][i >> 2][i & 3] + gab[i]);
                    la[i] = ga * sp[i];
                    uu[i] = __builtin_amdgcn_sqrtf(fmaxf(1.f - __expf(2.f * la[i]), 0.f)) * gx * xc[i];
                }
                *(u32x4*)(LLA + (size_t)row * 512 + ch) = pack8(la);
                *(u32x4*)(LU + (size_t)row * 512 + ch) = pack8(uu);
            }
            __builtin_amdgcn_sched_barrier(0);
        }
        return false;
    }
};

struct EpiMix {
    const Params* P;
    __device__ __forceinline__ bool operator()(Acc& acc, const Unit& u, int wr, int wc, int fr_, int fq_) const {
        int fr = fr_, fq = fq_; asm volatile("" : "+v"(fr), "+v"(fq));
        const int row0 = u.pm * BM + wr * 64 + fr, col0 = u.pn * BM + wc * 32 + 8 * fq;
        const bf16_t* proj = wsb(*P, PROJ_O);
        bf16_t* O = wsbw(*P, MIXIN_O);
#pragma unroll
        for (int am = 0; am < 4; ++am) {
            const int ai = am >> 1, m0 = (am & 1) * 2;
            u32x4 gbr[2][2], gar[2][2];
#pragma unroll
            for (int mm = 0; mm < 2; ++mm)
#pragma unroll
                for (int bj = 0; bj < 2; ++bj) {
                    const bf16_t* gp = proj + (size_t)(row0 + ai * HALF + (m0 + mm) * 16) * INC + 2304 + col0 + bj * HALF;
                    gbr[mm][bj] = *(const u32x4*)(gp + 1024);
                    if (u.kind == 0) gar[mm][bj] = *(const u32x4*)gp;
                }
#pragma unroll
            for (int mm = 0; mm < 2; ++mm) {
                const int m = m0 + mm, row = row0 + ai * HALF + m * 16;
#pragma unroll
                for (int bj = 0; bj < 2; ++bj) {
                    const int col = col0 + bj * HALF;
                    float gb[8];
                    unpack8(gbr[mm][bj], gb);
                    if (u.kind == 0) {
                        float ga[8];
                        unpack8(gar[mm][bj], ga);
#pragma unroll
                        for (int i = 0; i < 8; ++i) acc[ai][bj][m][i >> 2][i & 3] *= (1.f + __expf(-gb[i])) * rcp_(1.f + __expf(-ga[i]));
                    } else {
                        float v[8];
#pragma unroll
                        for (int i = 0; i < 8; ++i) v[i] = acc[ai][bj][m][i >> 2][i & 3] * sigm(gb[i]);
                        *(u32x4*)(O + (size_t)row * 1024 + col) = pack8(v);
                    }
                }
            }
            __builtin_amdgcn_sched_barrier(0);
        }
        return u.kind == 0;
    }
};

struct EpiUp {
    const Params* P;
    __device__ __forceinline__ bool operator()(Acc& acc, const Unit& u, int wr, int wc, int fr_, int fq_) const {
        int fr = fr_, fq = fq_; asm volatile("" : "+v"(fr), "+v"(fq));
        const int cg0 = u.pn * 128 + wc * 32 + 8 * fq;
        const float* cw = P->in[I_FCW]; const float* cbias = P->in[I_FCB];
        bf16_t* ACT = wsbw(*P, ACT_O);
        float* STASH = (float*)(P->ws + STASH_O);
#pragma unroll
        for (int n = 0; n < 2; ++n) {
            const int cg = cg0 + 4 * n;
            const f32x4 wg0 = *(const f32x4*)(cw + cg), wg1 = *(const f32x4*)(cw + DFF2 + cg), wg2 = *(const f32x4*)(cw + 2 * DFF2 + cg), bg = *(const f32x4*)(cbias + cg);
            const f32x4 wv0 = *(const f32x4*)(cw + DFF + cg), wv1 = *(const f32x4*)(cw + DFF2 + DFF + cg), wv2 = *(const f32x4*)(cw + 2 * DFF2 + DFF + cg), bv = *(const f32x4*)(cbias + DFF + cg);
            if (u.pm < 64) {
#pragma unroll
                for (int ai = 0; ai < 2; ++ai)
#pragma unroll
                    for (int m = 0; m < 4; ++m) {
                        const int rr = m * 16 + fr, row = u.pm * BM + ai * HALF + wr * 64 + rr;
                        const f32x4 g0 = acc[ai][0][m][n], v0 = acc[ai][1][m][n];
                        const f32x4 gp = acc[ai][0][m > 0 ? m - 1 : 0][n], vp = acc[ai][1][m > 0 ? m - 1 : 0][n];
                        float a[4], s1[8], s2[8];
#pragma unroll
                        for (int j = 0; j < 4; ++j) { s1[j] = fr == 15 ? gp[j] : g0[j]; s2[j] = fr >= 14 ? gp[j] : g0[j]; s1[4 + j] = fr == 15 ? vp[j] : v0[j]; s2[4 + j] = fr >= 14 ? vp[j] : v0[j]; }
                        __builtin_amdgcn_sched_barrier(0);
#pragma unroll
                        for (int j = 0; j < 8; ++j) { s1[j] = ror1(s1[j]); s2[j] = ror2(s2[j]); }
                        __builtin_amdgcn_sched_barrier(0);
#pragma unroll
                        for (int j = 0; j < 4; ++j) {
                            a[j] = gelu_t(fma_s(wg2[j], g0[j], fma_s(wg1[j], s1[j], fma_s(wg0[j], s2[j], bg[j]))));
                            a[j] *= fma_s(wv2[j], v0[j], fma_s(wv1[j], s1[4 + j], fma_s(wv0[j], s2[4 + j], bv[j])));
                        }
                        if (rr >= 2) {
                            u32x2 w; w.x = pk2(a[0], a[1]); w.y = pk2(a[2], a[3]);
                            *(u32x2*)(ACT + (size_t)row * DFF + cg) = w;
                        }
                        if (rr < 2 || rr >= 62) {
                            float* sp = STASH + ((size_t)(row >> 6) * 4 + (rr < 2 ? rr : rr - 60)) * DFF2;
                            *(f32x4*)(sp + cg) = g0; *(f32x4*)(sp + DFF + cg) = v0;
                        }
                        __builtin_amdgcn_sched_barrier(0);
                    }
            } else {
                float* SUP = (float*)(P->ws + SUP_O);
#pragma unroll
                for (int m = 0; m < 4; ++m) {
                    const int b = wr * 64 + m * 16 + fr;
                    *(f32x4*)(SUP + (size_t)b * DFF2 + cg) = acc[0][0][m][n]; *(f32x4*)(SUP + (size_t)b * DFF2 + DFF + cg) = acc[0][1][m][n];
                }
            }
        }
        return false;
    }
};

__device__ void phase0(const Params& P, LAS unsigned char* ldsb, int bid, int nb) {
    LAS float* tile = (LAS float*)ldsb;
    const int tid = TID(), wid = tid >> 6, lane = tid & 63;
    const int nt_in = 16 * 68, nt_a = 8 * 16, nt_b = 8 * 16, nt_o = 16 * 16, nt_up = 16 * 88, nt_dn = 44 * 16;
    const int total = (nb == 256) ? nt_in : nt_in + nt_a + nt_b + nt_o + nt_up + nt_dn;
    auto tile_info = [&](int j, const float*& src, bf16_t*& dst, int& K, int& N, int& k0, int& n0, int& drow0) {
        int jj = j, mode = 0;
        if (jj < nt_in) { src = P.in[I_WIN]; dst = wsbw(P, W_IN_T); K = 1024; N = 4352; }
        else if ((jj -= nt_in) < nt_a) { src = P.in[I_WOUT]; dst = wsbw(P, W_A_T); K = 512; N = 1024; }
        else if ((jj -= nt_a) < nt_b) { src = P.in[I_LWOUT]; dst = wsbw(P, W_B_T); K = 512; N = 1024; }
        else if ((jj -= nt_b) < nt_o) { src = P.in[I_WO]; dst = wsbw(P, W_O_T); K = 1024; N = 1024; }
        else if ((jj -= nt_o) < nt_up) { src = P.in[I_FUP]; dst = wsbw(P, W_UP_T); K = 1024; N = 5632; mode = 1; }
        else { jj -= nt_up; src = P.in[I_FDN]; dst = wsbw(P, W_DN_T); K = 2816; N = 1024; }
        const int ntn = N / 64; k0 = (jj / ntn) * 64; n0 = (jj % ntn) * 64;
        drow0 = n0;
        if (mode == 1) { if (n0 < DFF) drow0 = (n0 / 128) * 256 + (n0 % 128); else { const int q = n0 - DFF; drow0 = (q / 128) * 256 + 128 + (q % 128); } }
    };
    {
        f32x4 rv[2];
        const float* src; bf16_t* dst; int K, N, k0, n0, drow0;
        int j = bid;
        if (j < total) { tile_info(j, src, dst, K, N, k0, n0, drow0);
#pragma unroll
            for (int i = 0; i < 2; ++i) { const int idx = tid + 512 * i, kk = idx >> 4, n4 = (idx & 15) * 4; rv[i] = __builtin_nontemporal_load((const f32x4*)(src + (size_t)(k0 + kk) * N + n0 + n4)); } }
        while (j < total) {
#pragma unroll
            for (int i = 0; i < 2; ++i) { const int idx = tid + 512 * i, kk = idx >> 4, n4 = (idx & 15) * 4;
                tile[kk * 65 + n4] = rv[i].x; tile[kk * 65 + n4 + 1] = rv[i].y; tile[kk * 65 + n4 + 2] = rv[i].z; tile[kk * 65 + n4 + 3] = rv[i].w; }
            bf16_t* cdst = dst; const int cK = K, ck0 = k0, cdrow0 = drow0;
            j += nb;
            if (j < total) { tile_info(j, src, dst, K, N, k0, n0, drow0);
#pragma unroll
                for (int i = 0; i < 2; ++i) { const int idx = tid + 512 * i, kk = idx >> 4, n4 = (idx & 15) * 4; rv[i] = __builtin_nontemporal_load((const f32x4*)(src + (size_t)(k0 + kk) * N + n0 + n4)); } }
            asm volatile("s_waitcnt lgkmcnt(0)\n\ts_barrier" ::: "memory");
#pragma unroll
            for (int i = 0; i < 4; ++i) { const int idx = tid + 512 * i, nn = idx >> 5, kp = idx & 31;
                *(unsigned*)(cdst + (size_t)(cdrow0 + nn) * cK + ck0 + 2 * kp) = pk2(tile[(2 * kp) * 65 + nn], tile[(2 * kp + 1) * 65 + nn]); }
            asm volatile("s_waitcnt lgkmcnt(0)\n\ts_barrier" ::: "memory");
        }
    }
    const int gtid = bid * 512 + tid, gth = nb * 512;
    { bf16_t* W = wsbw(P, W_LORA_T);
      for (int idx = gtid; idx < 256 * 512; idx += gth) { const int k = idx >> 9, n = idx & 511;
          const float v = k < 64 ? P.in[I_WUP][k * 512 + n] : (k < 128 ? P.in[I_AUP][(k - 64) * 512 + n] : P.in[I_GUP][(k - 128) * 512 + n]);
          const int sec = k < 64 ? 0 : (k < 128 ? 1 : 2);
#pragma unroll
          for (int t = 0; t < 3; ++t) W[(size_t)(t * 512 + n) * 256 + k] = (t == sec) ? f2bf(v) : (bf16_t)0; } }
    { bf16_t* W = wsbw(P, W_LRUG_T);
      for (int idx = gtid; idx < 512 * 1024; idx += gth) { const int k = idx >> 10, n = idx & 1023; const int pn = n >> 8, wi = n & 255, ch = pn * 128 + (wi & 127), blk = ch >> 6, jc = ch & 63;
          float v = 0.f; if ((k >> 6) == blk) v = (wi >= 128 ? P.in[I_GAW] : P.in[I_GXW])[blk * 4096 + (k & 63) * 64 + jc];
          W[(size_t)n * 512 + k] = f2bf(v); } }
    { float* r1 = (float*)(P.ws + ROWSS1); float* r2 = (float*)(P.ws + ROWSS2);
      for (int idx = gtid; idx < MPAD; idx += gth) { r1[idx] = 0.f; r2[idx] = 0.f; } }
    bf16_t* XN = wsbw(P, XN_O);
    for (int rowA = bid * 8 + wid; rowA < MP; rowA += nb * 16) {
        const int rowB = rowA + nb * 8; const bool hasB = rowB < MP; const int rows[2] = {rowA, hasB ? rowB : rowA};
        f32x4 v[2][4]; float ss[2] = {0.f, 0.f};
#pragma unroll
        for (int q = 0; q < 2; ++q)
#pragma unroll
            for (int i = 0; i < 4; ++i) v[q][i] = __builtin_nontemporal_load((const f32x4*)(P.in[I_XP] + (size_t)rows[q] * 1024 + lane * 4 + 256 * i));
#pragma unroll
        for (int q = 0; q < 2; ++q)
#pragma unroll
            for (int i = 0; i < 4; ++i) ss[q] += v[q][i].x * v[q][i].x + v[q][i].y * v[q][i].y + v[q][i].z * v[q][i].z + v[q][i].w * v[q][i].w;
        ss[0] = wave_sum(ss[0]); ss[1] = wave_sum(ss[1]);
#pragma unroll
        for (int q = 0; q < 2; ++q) { const float sc = rsqrtf(ss[q] * (1.f / 1024.f) + 1e-6f);
            if (q == 0 || hasB) {
#pragma unroll
                for (int i = 0; i < 4; ++i) { const f32x4 g = *(const f32x4*)(P.in[I_NPM] + lane * 4 + 256 * i); const f32x4 t = v[q][i] * sc * g;
                    u32x2 w; w.x = pk2(t.x, t.y); w.y = pk2(t.z, t.w); *(u32x2*)(XN + (size_t)rows[q] * 1024 + lane * 4 + 256 * i) = w; } } }
    }
    for (int row = MP + bid * 8 + wid; row < MPAD; row += nb * 8) {
        bf16_t* o = XN + (size_t)row * 1024;
        if (row >= MT) { for (int i = 0; i < 4; ++i) *(u32x2*)(o + lane * 4 + 256 * i) = (u32x2){0u, 0u}; continue; }
        const float* x = row < MP ? P.in[I_XP] + (size_t)row * 1024 : P.in[I_XS] + (size_t)(row - MP) * 1024;
        f32x4 v[4]; float ss = 0.f;
#pragma unroll
        for (int i = 0; i < 4; ++i) { v[i] = *(const f32x4*)(x + lane * 4 + 256 * i); ss += v[i].x * v[i].x + v[i].y * v[i].y + v[i].z * v[i].z + v[i].w * v[i].w; }
        ss = wave_sum(ss);
        const float sc = rsqrtf(ss * (1.f / 1024.f) + 1e-6f);
#pragma unroll
        for (int i = 0; i < 4; ++i) { const f32x4 g = *(const f32x4*)(P.in[I_NPM] + lane * 4 + 256 * i);
            u32x2 w; w.x = pk2(v[i].x * sc * g.x, v[i].y * sc * g.y); w.y = pk2(v[i].z * sc * g.z, v[i].w * sc * g.w); *(u32x2*)(o + lane * 4 + 256 * i) = w; }
    }
}

__device__ void phase_b0(const Params& P, int bid, int nb) {
    const int tid = TID(), wid = tid >> 6, lane = tid & 63;
    const bf16_t* proj = wsb(P, PROJ_O);
    bf16_t* LA = outb(P, LA_O); bf16_t* XC = outb(P, XC_O); bf16_t* KK = wsbw(P, KK_O);
    for (int row = bid * 8 + wid; row < MPAD; row += nb * 8) {
        if (row >= MT) {
            const u32x4 z = (u32x4){0u, 0u, 0u, 0u};
            if (lane < 32) *(u32x4*)(LA + (size_t)row * 256 + 8 * lane) = z;
            *(u32x4*)(XC + (size_t)row * 512 + 8 * lane) = z; *(u32x4*)(KK + (size_t)row * 512 + 8 * lane) = z;
            continue;
        }
        const bool sample = row >= MP; const int b = sample ? row - MP : row >> 11, t = sample ? 0 : (row & 2047);
        float m[8];
        { shifted8(P, row, 512 + 8 * lane, m);
          float kk[8], kkw[8]; ld8f(P.in[I_KK] + 8 * lane, kkw); float ss = 0.f;
#pragma unroll
          for (int i = 0; i < 8; ++i) { kk[i] = m[i] * kkw[i]; ss += kk[i] * kk[i]; }
          ss += __shfl_xor(ss, 1); ss += __shfl_xor(ss, 2); ss += __shfl_xor(ss, 4);
          const float inv = 1.f / fmaxf(sqrtf(ss), 1e-12f);
#pragma unroll
          for (int i = 0; i < 8; ++i) kk[i] *= inv;
          *(u32x4*)(KK + (size_t)row * 512 + 8 * lane) = pack8(kk); }
        if (lane < 32) {
            shifted8(P, row, 1536 + 8 * lane, m);
            if (lane < 8) { for (int i = 0; i < 8; ++i) m[i] = tanh_(m[i]); }
            else if (lane >= 16) { for (int i = 0; i < 8; ++i) m[i] = sigm(m[i]); }
            *(u32x4*)(LA + (size_t)row * 256 + 8 * lane) = pack8(m);
        }
        { const int c0 = 8 * lane; float x0[8], x1[8], x2[8], x3[8];
          ld8bf(proj + (size_t)row * INC + RP + c0, x3);
          if (sample) { const float* sb = P.in[I_SLCONV] + (size_t)b * 3 * 512 + c0; ld8f(sb, x0); ld8f(sb + 512, x1); ld8f(sb + 1024, x2); }
          else {
              if (t >= 1) ld8bf(proj + (size_t)(row - 1) * INC + RP + c0, x2); else { for (int i = 0; i < 8; ++i) x2[i] = 0.f; }
              if (t >= 2) ld8bf(proj + (size_t)(row - 2) * INC + RP + c0, x1); else { for (int i = 0; i < 8; ++i) x1[i] = 0.f; }
              if (t >= 3) ld8bf(proj + (size_t)(row - 3) * INC + RP + c0, x0); else { for (int i = 0; i < 8; ++i) x0[i] = 0.f; }
          }
          float w0[8], w1[8], w2[8], w3[8], cb[8], xc[8];
          ld8f(P.in[I_LCW] + c0, w0); ld8f(P.in[I_LCW] + 512 + c0, w1); ld8f(P.in[I_LCW] + 1024 + c0, w2); ld8f(P.in[I_LCW] + 1536 + c0, w3); ld8f(P.in[I_LCB] + c0, cb);
#pragma unroll
          for (int i = 0; i < 8; ++i) xc[i] = cb[i] + w0[i] * x0[i] + w1[i] * x1[i] + w2[i] * x2[i] + w3[i] * x3[i];
          *(u32x4*)(XC + (size_t)row * 512 + c0) = pack8(xc);
          if (sample) { float* o = P.out + O_SLCONV + (size_t)b * 3 * 512 + c0; st8f(o, x1); st8f(o + 512, x2); st8f(o + 1024, x3); }
          else if (t == 2047) { float* o = P.out + O_PLCONV + (size_t)b * 3 * 512 + c0; st8f(o, x1); st8f(o + 512, x2); st8f(o + 1024, x3); }
        }
        if (sample || t == 2047) {
            float* o = P.out + (sample ? O_SSHIFT : O_PSHIFT) + (size_t)b * RP;
            for (int ci = lane; ci < 224; ci += 64) { float p[8]; ld8bf(proj + (size_t)row * INC + 8 * ci, p); st8f(o + 8 * ci, p); }
        }
    }
}

__device__ __forceinline__ void sample_wkv(const Params& P, int w0, int nw) {
    const int lane = TID() & 63, rowq = lane >> 4, kq = lane & 15;
    const bf16_t* proj = wsb(P, PROJ_O);
    const bf16_t* E = wsb(P, E_O); const bf16_t* AS = wsb(P, ASIG_O); const bf16_t* KK = wsb(P, KK_O);
    bf16_t* Y = wsbw(P, Y_O);
    for (int it = w0; it < 128 * 8; it += nw) {
        const int b = it >> 3, h = it & 7, row = MP + b, hc = h * 64 + 4 * kq, vc = 1024 + h * 64 + lane;
        const bf16_t* pr = proj + (size_t)row * INC; const float* sh = P.in[I_SSHIFT] + (size_t)b * RP; const float* mu = P.in[I_MU];
        const float* S0 = P.in[I_SWKV] + (size_t)(b * 8 + h) * 4096;
        float* S1 = P.out + O_SWKV + (size_t)(b * 8 + h) * 4096;
        f32x4 st[8];
#pragma unroll
        for (int i = 0; i < 8; ++i) st[i] = __builtin_nontemporal_load((const f32x4*)(S0 + (4 * i + rowq) * 64 + 4 * kq));
        const u32x2 pr_r = *(const u32x2*)(pr + hc), pr_k = *(const u32x2*)(pr + 512 + hc);
        const f32x4 sh_r = *(const f32x4*)(sh + hc), sh_k = *(const f32x4*)(sh + 512 + hc), mu_r = *(const f32x4*)(mu + hc), mu_k = *(const f32x4*)(mu + 512 + hc);
        const f32x4 ka = *(const f32x4*)(P.in[I_KA] + hc);
        const u32x2 a4 = *(const u32x2*)(AS + (size_t)row * 512 + hc), kk4 = *(const u32x2*)(KK + (size_t)row * 512 + hc), e4 = *(const u32x2*)(E + (size_t)row * 512 + hc);
        const float pvv = bf1(pr[vc]), shv = sh[vc], muv = mu[vc];
        const float mv = pvv + muv * (shv - pvv);
        const float pr_[4] = {bflo(pr_r.x), bfhi(pr_r.x), bflo(pr_r.y), bfhi(pr_r.y)}, pk_[4] = {bflo(pr_k.x), bfhi(pr_k.x), bflo(pr_k.y), bfhi(pr_k.y)};
        const float a_[4] = {bflo(a4.x), bfhi(a4.x), bflo(a4.y), bfhi(a4.y)}, kk_[4] = {bflo(kk4.x), bfhi(kk4.x), bflo(kk4.y), bfhi(kk4.y)}, e_[4] = {bflo(e4.x), bfhi(e4.x), bflo(e4.y), bfhi(e4.y)};
        float d[4], kp[4], na[4], nbv[4], r[4];
#pragma unroll
        for (int i = 0; i < 4; ++i) {
            r[i] = pr_[i] + mu_r[i] * (sh_r[i] - pr_[i]);
            const float mk = pk_[i] + mu_k[i] * (sh_k[i] - pk_[i]);
            d[i] = __expf(-e_[i]); kp[i] = mk * (1.f + (a_[i] - 1.f) * ka[i]); na[i] = -kk_[i]; nbv[i] = kk_[i] * a_[i];
        }
        { const f32x4 rk4 = *(const f32x4*)(P.in[I_RK] + hc);
          float bo = r[0] * kp[0] * rk4[0] + r[1] * kp[1] * rk4[1] + r[2] * kp[2] * rk4[2] + r[3] * kp[3] * rk4[3];
          bo = row16_sum(bo);
          if (lane == 0) ((float*)(P.ws + BON_O))[(size_t)row * 8 + h] = bo; }
#pragma unroll
        for (int i = 0; i < 16; ++i) {
            const int v = 4 * i + rowq;
            if (i == 8) {
#pragma unroll
                for (int i2 = 0; i2 < 8; ++i2) st[i2] = __builtin_nontemporal_load((const f32x4*)(S0 + (4 * (8 + i2) + rowq) * 64 + 4 * kq));
            }
            f32x4 s = st[i & 7];
            const float vv = __shfl(mv, v);
            float sa = s.x * na[0] + s.y * na[1] + s.z * na[2] + s.w * na[3];
            sa = row16_sum(sa);
            s.x = s.x * d[0] + sa * nbv[0] + vv * kp[0]; s.y = s.y * d[1] + sa * nbv[1] + vv * kp[1];
            s.z = s.z * d[2] + sa * nbv[2] + vv * kp[2]; s.w = s.w * d[3] + sa * nbv[3] + vv * kp[3];
            float y = s.x * r[0] + s.y * r[1] + s.z * r[2] + s.w * r[3];
            y = row16_sum(y);
            *(f32x4*)(S1 + v * 64 + 4 * kq) = s;
            if (kq == 0) Y[(size_t)row * 512 + h * 64 + v] = f2bf(y);
        }
    }
}

typedef float f32x2 __attribute__((ext_vector_type(2)));
__device__ __forceinline__ void lru_pass1(const Params& P, int t0, int nt) {
    const bf16_t* LLA = outb(P, LLA_O); const bf16_t* LU = outb(P, LU_O);
    f32x2* CP = (f32x2*)(P.ws + CARRY_P); f32x2* CH = (f32x2*)(P.ws + CARRY_H);
    for (int idx = t0; idx < 8 * 64 * 256; idx += nt) {
        const int c2 = idx & 255, chunk = (idx >> 8) & 63, b = idx >> 14;
        const size_t base = ((size_t)b * 2048 + chunk * 32) * 512 + 2 * c2;
        float h0 = 0.f, h1 = 0.f, s0 = 0.f, s1 = 0.f;
#pragma unroll 1
        for (int hb = 0; hb < 2; ++hb) {
            unsigned la[16], uu[16];
#pragma unroll
            for (int t = 0; t < 16; ++t) { la[t] = __builtin_nontemporal_load((const unsigned*)(LLA + base + (size_t)(hb * 16 + t) * 512)); uu[t] = __builtin_nontemporal_load((const unsigned*)(LU + base + (size_t)(hb * 16 + t) * 512)); }
#pragma unroll
            for (int t = 0; t < 16; ++t) { const float a0 = bflo(la[t]), a1 = bfhi(la[t]); h0 = __expf(a0) * h0 + bflo(uu[t]); h1 = __expf(a1) * h1 + bfhi(uu[t]); s0 += a0; s1 += a1; }
        }
        CP[idx] = (f32x2){s0, s1}; CH[idx] = (f32x2){h0, h1};
    }
}
__device__ __forceinline__ void sample_lru(const Params& P, int t0, int nt) {
    const bf16_t* LLA = outb(P, LLA_O); bf16_t* LU = outb(P, LU_O);
    for (int idx = t0; idx < 256 * 512; idx += nt) {
        const int c = idx & 511, b = idx >> 9; const size_t o = (size_t)(MP + b) * 512 + c;
        if (b < 128) { const float h = __expf(bf1(LLA[o])) * P.in[I_SLH][b * 512 + c] + bf1(LU[o]); P.out[O_SLH + b * 512 + c] = h; LU[o] = f2bf(h); }
        else LU[o] = 0;
    }
}
__device__ void lru_pass2(const Params& P, int bid, int nb) {
    const bf16_t* LLA = outb(P, LLA_O); bf16_t* LU = outb(P, LU_O);
    const f32x2* CP = (const f32x2*)(P.ws + CARRY_P); const f32x2* CH = (const f32x2*)(P.ws + CARRY_H);
    for (int idx = bid * 512 + TID(); idx < 8 * 64 * 256; idx += nb * 512) {
        const int c2 = idx & 255, chunk = (idx >> 8) & 63, b = idx >> 14;
        const size_t base = ((size_t)b * 2048 + chunk * 32) * 512 + 2 * c2;
        unsigned la[32], uu[32];
#pragma unroll
        for (int t = 0; t < 32; ++t) { la[t] = __builtin_nontemporal_load((const unsigned*)(LLA + base + (size_t)t * 512)); uu[t] = __builtin_nontemporal_load((const unsigned*)(LU + base + (size_t)t * 512)); }
        float h0 = 0.f, h1 = 0.f;
        for (int j0 = 0; j0 < chunk; j0 += 16) {
            f32x2 cp[16], ch[16];
#pragma unroll
            for (int i = 0; i < 16; ++i) { const int j = (j0 + i < chunk) ? j0 + i : chunk - 1; const int k = ((b * 64 + j) << 8) + c2; cp[i] = CP[k]; ch[i] = CH[k]; }
#pragma unroll
            for (int i = 0; i < 16; ++i) if (j0 + i < chunk) { h0 = __expf(cp[i].x) * h0 + ch[i].x; h1 = __expf(cp[i].y) * h1 + ch[i].y; }
        }
#pragma unroll
        for (int t = 0; t < 32; ++t) { h0 = __expf(bflo(la[t])) * h0 + bflo(uu[t]); h1 = __expf(bfhi(la[t])) * h1 + bfhi(uu[t]); *(unsigned*)(LU + base + (size_t)t * 512) = pk2(h0, h1); }
        if (chunk == 63) *(f32x2*)(P.out + O_PLH + b * 512 + 2 * c2) = (f32x2){h0, h1};
    }
}

constexpr int WT_A = 64 * 16, WT_B = 64 * 16, WT_O = 128 * 16, WT_UP = 128 * 88, WT_DN = 352 * 16, WT_TOTAL = WT_A + WT_B + WT_O + WT_UP + WT_DN;
__device__ __forceinline__ void wt_task(const Params& P, int task, int lane, const float*& src, int& N, bf16_t*& dstp) {
    int j = task, K, mode = 0; bf16_t* dst;
    if (j < WT_A) { src = P.in[I_WOUT]; dst = wsbw(P, W_A_T); K = 512; N = 1024; }
    else if ((j -= WT_A) < WT_B) { src = P.in[I_LWOUT]; dst = wsbw(P, W_B_T); K = 512; N = 1024; }
    else if ((j -= WT_B) < WT_O) { src = P.in[I_WO]; dst = wsbw(P, W_O_T); K = 1024; N = 1024; }
    else if ((j -= WT_O) < WT_UP) { src = P.in[I_FUP]; dst = wsbw(P, W_UP_T); K = 1024; N = 5632; mode = 1; }
    else { j -= WT_UP; src = P.in[I_FDN]; dst = wsbw(P, W_DN_T); K = 2816; N = 1024; }
    const int ntn = N / 64, k0 = (j / ntn) * 8, n = (j % ntn) * 64 + lane;
    int drow = n;
    if (mode == 1) { if (n < DFF) drow = (n / 128) * 256 + (n % 128); else { const int q = n - DFF; drow = (q / 128) * 256 + 128 + (q % 128); } }
    src += (size_t)k0 * N + n; dstp = dst + (size_t)drow * K + k0;
}

constexpr int CHS = 32, REC = 388, NCH = 2048 / CHS;
#define SC_BAR() asm volatile("s_waitcnt lgkmcnt(0)\n\ts_barrier" ::: "memory")
template <bool EXTRAS>
__device__ void wkv_scan(const Params& P, int it, LAS float* lds, int bid, int nb) {
    const int tid = TID(), wid = __builtin_amdgcn_readfirstlane(tid >> 6), lane = tid & 63;
    const int xcd = it & 7, jj = it >> 3, s = jj & 3, bh = xcd + 8 * (jj >> 2), b = bh >> 3, h = bh & 7;
    LAS float* buf0 = lds; LAS float* buf1 = lds + CHS * REC; LAS float* yb = lds + 2 * CHS * REC;
    const size_t rowbase = (size_t)b * 2048;
    if (wid >= 4) {
        const int p = tid - 256, st = p >> 3, c8 = (p & 7) * 8, hc = h * 64 + c8;
        const bf16_t* proj = wsb(P, PROJ_O); const bf16_t* E = wsb(P, E_O); const bf16_t* AS = wsb(P, ASIG_O); const bf16_t* KK = wsb(P, KK_O);
        bf16_t* Y_ = wsbw(P, Y_O);
        float mur[8], muk[8], muv[8], ka[8];
        ld8f(P.in[I_MU] + hc, mur); ld8f(P.in[I_MU] + 512 + hc, muk); ld8f(P.in[I_MU] + 1024 + hc, muv); ld8f(P.in[I_KA] + hc, ka);
        struct Raw { u32x4 r, k, v, rp, kp, vp, e, a, kk; };
        Raw X, Y;
#define SC_LOAD(L, chunk) do { const int t_ = (chunk) * CHS + st; const size_t row_ = rowbase + t_; const bf16_t* pr_ = proj + row_ * INC + hc; \
        L.r = *(const u32x4*)pr_; L.k = *(const u32x4*)(pr_ + 512); L.v = *(const u32x4*)(pr_ + 1024); \
        if (t_ > 0) { L.rp = *(const u32x4*)(pr_ - INC); L.kp = *(const u32x4*)(pr_ - INC + 512); L.vp = *(const u32x4*)(pr_ - INC + 1024); } \
        else { L.rp = (u32x4){0u, 0u, 0u, 0u}; L.kp = L.rp; L.vp = L.rp; } \
        L.e = *(const u32x4*)(E + row_ * 512 + hc); L.a = *(const u32x4*)(AS + row_ * 512 + hc); L.kk = *(const u32x4*)(KK + row_ * 512 + hc); } while (0)
#define SC_WRITE(L, buf, chunk) do { LAS float* rec_ = (buf) + st * REC + c8; float r_[8], rp_[8], k_[8], kpv_[8], v_[8], vp_[8], e_[8], a_[8], kk_[8]; \
        unpack8(L.r, r_); unpack8(L.rp, rp_); unpack8(L.k, k_); unpack8(L.kp, kpv_); unpack8(L.v, v_); unpack8(L.vp, vp_); unpack8(L.e, e_); unpack8(L.a, a_); unpack8(L.kk, kk_); \
        float od_[8], ok_[8], ona_[8], onb_[8], or_[8], ov_[8]; \
        _Pragma("unroll") for (int i = 0; i < 8; ++i) { or_[i] = r_[i] + mur[i] * (rp_[i] - r_[i]); const float mk_ = k_[i] + muk[i] * (kpv_[i] - k_[i]); ov_[i] = v_[i] + muv[i] * (vp_[i] - v_[i]); \
            od_[i] = __expf(-e_[i]); ok_[i] = mk_ * (1.f + (a_[i] - 1.f) * ka[i]); ona_[i] = -kk_[i]; onb_[i] = kk_[i] * a_[i]; } \
        LAS float* nd_ = (buf) + st * REC + c8; \
        *(LAS f32x4*)(nd_) = (f32x4){ona_[0], od_[0] * or_[0], ona_[1], od_[1] * or_[1]}; *(LAS f32x4*)(nd_ + 64) = (f32x4){ona_[2], od_[2] * or_[2], ona_[3], od_[3] * or_[3]}; \
        *(LAS f32x4*)(nd_ + 4) = (f32x4){ona_[4], od_[4] * or_[4], ona_[5], od_[5] * or_[5]}; *(LAS f32x4*)(nd_ + 68) = (f32x4){ona_[6], od_[6] * or_[6], ona_[7], od_[7] * or_[7]}; \
        *(LAS f32x4*)(rec_ + 128) = (f32x4){od_[0], od_[1], od_[2], od_[3]}; *(LAS f32x4*)(rec_ + 132) = (f32x4){od_[4], od_[5], od_[6], od_[7]}; \
        *(LAS f32x4*)(rec_ + 192) = (f32x4){ok_[0], ok_[1], ok_[2], ok_[3]}; *(LAS f32x4*)(rec_ + 196) = (f32x4){ok_[4], ok_[5], ok_[6], ok_[7]}; \
        *(LAS f32x4*)(rec_ + 256) = (f32x4){onb_[0], onb_[1], onb_[2], onb_[3]}; *(LAS f32x4*)(rec_ + 260) = (f32x4){onb_[4], onb_[5], onb_[6], onb_[7]}; \
        { float c1_ = 0.f, c2_ = 0.f, bo_ = 0.f; float rkc_[8]; ld8f(P.in[I_RK] + hc, rkc_);     \
          _Pragma("unroll") for (int i = 0; i < 8; ++i) { c1_ += onb_[i] * or_[i]; c2_ += ok_[i] * or_[i]; bo_ += ok_[i] * or_[i] * rkc_[i]; } \
          c1_ += __shfl_xor(c1_, 1); c2_ += __shfl_xor(c2_, 1); bo_ += __shfl_xor(bo_, 1); c1_ += __shfl_xor(c1_, 2); c2_ += __shfl_xor(c2_, 2); bo_ += __shfl_xor(bo_, 2); \
          c1_ += __shfl_xor(c1_, 4); c2_ += __shfl_xor(c2_, 4); bo_ += __shfl_xor(bo_, 4); \
          if (s == 0 && (p & 7) == 0) ((float*)(P.ws + BON_O))[(rowbase + (chunk) * CHS + st) * 8 + h] = bo_; \
          LAS float* rs_ = (buf) + st * REC + 320 + 8 * (p & 7); *(LAS f32x2*)(rs_) = (f32x2){c1_, c2_}; *(LAS f32x2*)(rs_ + 4) = (f32x2){c1_, c2_}; } \
        if ((c8 >> 4) == s) { LAS float* vr_ = (buf) + st * REC + 320 + 4 * (c8 & 15) + 2; _Pragma("unroll") for (int i = 0; i < 8; ++i) vr_[4 * i] = ov_[i]; } } while (0)
#define SC_FLUSH(chunk) do { const LAS float* yy_ = yb + ((chunk) & 1) * CHS * 16 + st * 16 + 2 * (p & 7); \
        *(unsigned*)(Y_ + (rowbase + (chunk) * CHS + st) * 512 + h * 64 + 16 * s + 2 * (p & 7)) = pk2(yy_[0], yy_[1]); } while (0)
        SC_LOAD(X, 0); SC_LOAD(Y, 1); SC_WRITE(X, buf0, 0); SC_LOAD(X, 2);
        SC_BAR();
        for (int c = 0; c < NCH; c += 2) {
            if (c + 1 < NCH) SC_WRITE(Y, buf1, c + 1);
            if (c + 3 < NCH) SC_LOAD(Y, c + 3);
            if (c > 0) SC_FLUSH(c - 1);
            float wtv[8]; bf16_t* wtd = nullptr;
            if (EXTRAS) {
                int pp = p; asm volatile("" : "+v"(pp));
                if (c == 46) lru_pass1(P, bid * 256 + pp, nb * 256);
                else if (c == 50) sample_lru(P, bid * 256 + pp, nb * 256);
                else if (c == 54) sample_wkv(P, bid * 4 + (pp >> 6), nb * 4);
                const int task = (c < 44) ? bid * 4 + (pp >> 6) + nb * 4 * (c >> 1) : WT_TOTAL;
                if (task < WT_TOTAL) { const float* src; int N;
                    wt_task(P, task, pp & 63, src, N, wtd);
#pragma unroll
                    for (int i = 0; i < 8; ++i) wtv[i] = __builtin_nontemporal_load(src + (size_t)i * N); }
            }
            SC_BAR();
            if (EXTRAS && wtd) { u32x4 w0; w0.x = pk2(wtv[0], wtv[1]); w0.y = pk2(wtv[2], wtv[3]); w0.z = pk2(wtv[4], wtv[5]); w0.w = pk2(wtv[6], wtv[7]); *(u32x4*)wtd = w0; }
            if (c + 2 < NCH) SC_WRITE(X, buf0, c + 2);
            if (c + 4 < NCH) SC_LOAD(X, c + 4);
            SC_FLUSH(c);
            SC_BAR();
        }
        SC_FLUSH(NCH - 1);
#undef SC_LOAD
#undef SC_WRITE
#undef SC_FLUSH
    } else {
        const int rowq = lane >> 4, kq = lane & 15, rloc = 4 * wid + rowq;
        f32x4 S = (f32x4){0.f, 0.f, 0.f, 0.f};
        struct Ops { f32x4 nd0, nd1, d, kp, nb, rs; };
#define SC_LD(X, st_) do { X.nd0 = *(const LAS f32x4*)(bk4 + (st_) * REC - 128); X.nd1 = *(const LAS f32x4*)(bk4 + (st_) * REC - 64); \
        X.d = *(const LAS f32x4*)(bk4 + (st_) * REC); X.kp = *(const LAS f32x4*)(bk4 + (st_) * REC + 64); X.nb = *(const LAS f32x4*)(bk4 + (st_) * REC + 128); \
        X.rs = *(const LAS f32x4*)(br + (st_) * REC); } while (0)
#define SC_STEP(X, j_) do { f32x2 p_ = (f32x2){S.x, S.x} * (f32x2){X.nd0.x, X.nd0.y}; p_ = (f32x2){S.y, S.y} * (f32x2){X.nd0.z, X.nd0.w} + p_; \
        p_ = (f32x2){S.z, S.z} * (f32x2){X.nd1.x, X.nd1.y} + p_; p_ = (f32x2){S.w, S.w} * (f32x2){X.nd1.z, X.nd1.w} + p_; \
        const f32x4 T_ = S * X.d + X.rs.z * X.kp; \
        float sa_ = p_.x, q_ = p_.y; \
        sa_ += dppf<0xB1>(sa_); q_ += dppf<0xB1>(q_); sa_ += dppf<0x4E>(sa_); q_ += dppf<0x4E>(q_); sa_ += dppf<0x141>(sa_); q_ += dppf<0x141>(q_); sa_ += dppf<0x140>(sa_); q_ += dppf<0x140>(q_); \
        S = T_ + sa_ * X.nb; \
        const float y_ = q_ + sa_ * X.rs.x + X.rs.z * X.rs.y; yacc = (kq == (j_)) ? y_ : yacc; } while (0)
        SC_BAR();
        for (int c = 0; c < NCH; ++c) {
            const LAS float* bufc = (c & 1) ? buf1 : buf0; LAS float* ybc = yb + (c & 1) * CHS * 16;
            const LAS float* bk4 = bufc + 128 + 4 * kq; const LAS float* br = bufc + 320 + 4 * rloc;
            Ops A, B;
            SC_LD(A, 0);
#pragma unroll
            for (int g = 0; g < 2; ++g) {
                float yacc = 0.f;
#pragma unroll
                for (int j = 0; j < 16; j += 2) {
                    SC_LD(B, g * 16 + j + 1);
                    SC_STEP(A, j);
                    __builtin_amdgcn_sched_barrier(0);
                    if (g * 16 + j + 2 < CHS) SC_LD(A, g * 16 + j + 2);
                    SC_STEP(B, j + 1);
                    __builtin_amdgcn_sched_barrier(0);
                }
                ybc[(g * 16 + kq) * 16 + rloc] = yacc;
            }
            SC_BAR();
        }
#undef SC_LD
#undef SC_STEP
        *(f32x4*)(P.out + O_PWKV + ((size_t)(b * 8 + h) * 64 + 16 * s + rloc) * 64 + 4 * kq) = S;
    }
}

__device__ void phase_za(const Params& P, int bid, int nb) {
    const int tid = TID(), wid = tid >> 6, lane = tid & 63, c0 = 8 * lane;
    const bf16_t* G = wsb(P, G_O); const bf16_t* Y = wsb(P, Y_O);
    bf16_t* ZA = outb(P, ZA_O);
    for (int row = bid * 8 + wid; row < MPAD; row += nb * 8) {
        if (row >= MT) { *(u32x4*)(ZA + (size_t)row * 512 + c0) = (u32x4){0u, 0u, 0u, 0u}; continue; }
        float v[8], y[8], g[8], lw[8], lb[8], za[8];
        shifted8(P, row, 1024 + c0, v);
        ld8bf_nt(Y + (size_t)row * 512 + c0, y); ld8bf_nt(G + (size_t)row * 512 + c0, g);
        ld8f(P.in[I_LNW] + c0, lw); ld8f(P.in[I_LNB] + c0, lb);
        const float sb = ((const float*)(P.ws + BON_O))[(size_t)row * 8 + (lane >> 3)];
        float sy = 0.f;
#pragma unroll
        for (int i = 0; i < 8; ++i) sy += y[i];
        sy += __shfl_xor(sy, 1); sy += __shfl_xor(sy, 2); sy += __shfl_xor(sy, 4);
        const float mean = sy * (1.f / 64.f);
        float sv = 0.f;
#pragma unroll
        for (int i = 0; i < 8; ++i) { const float dd = y[i] - mean; sv += dd * dd; }
        sv += __shfl_xor(sv, 1); sv += __shfl_xor(sv, 2); sv += __shfl_xor(sv, 4);
        const float rs = rsqrtf(sv * (1.f / 64.f) + 64e-5f);
#pragma unroll
        for (int i = 0; i < 8; ++i) za[i] = ((y[i] - mean) * rs * lw[i] + lb[i] + sb * v[i]) * g[i];
        *(u32x4*)(ZA + (size_t)row * 512 + c0) = pack8(za);
    }
}

__device__ void phase_e(const Params& P, int bid, int nb) {
    const int tid = TID(), wid = tid >> 6, lane = tid & 63;
    const bf16_t* MIX = wsb(P, MIX_O); bf16_t* HN = wsbw(P, HN_O); const float* rss = (const float*)(P.ws + ROWSS1);
    for (int rowA = bid * 8 + wid; rowA < MP; rowA += nb * 16) {
        const int rowB = rowA + nb * 8; const bool hasB = rowB < MP; const int rB = hasB ? rowB : rowA;
        const int rows[2] = {rowA, rB};
        f32x4 xv[2][4]; u32x2 mb[2][4]; float rs[2];
#pragma unroll
        for (int q = 0; q < 2; ++q) { rs[q] = rss[rows[q]];
#pragma unroll
            for (int i = 0; i < 4; ++i) { const int c = lane * 4 + 256 * i; xv[q][i] = __builtin_nontemporal_load((const f32x4*)(P.in[I_XP] + (size_t)rows[q] * 1024 + c)); mb[q][i] = __builtin_nontemporal_load((const u32x2*)(MIX + (size_t)rows[q] * 1024 + c)); } }
        f32x4 g1[4], g2[4];
#pragma unroll
        for (int i = 0; i < 4; ++i) { g1[i] = *(const f32x4*)(P.in[I_NPOM] + lane * 4 + 256 * i); g2[i] = *(const f32x4*)(P.in[I_NPF] + lane * 4 + 256 * i); }
        float ss[2];
#pragma unroll
        for (int q = 0; q < 2; ++q) { const float sc = rsqrtf(rs[q] * (1.f / 1024.f) + 1e-6f); ss[q] = 0.f;
#pragma unroll
            for (int i = 0; i < 4; ++i) { const f32x4 m = (f32x4){bflo(mb[q][i].x), bfhi(mb[q][i].x), bflo(mb[q][i].y), bfhi(mb[q][i].y)};
                xv[q][i] = xv[q][i] + m * sc * g1[i];
                ss[q] += xv[q][i].x * xv[q][i].x + xv[q][i].y * xv[q][i].y + xv[q][i].z * xv[q][i].z + xv[q][i].w * xv[q][i].w; } }
        ss[0] = wave_sum(ss[0]); ss[1] = wave_sum(ss[1]);
#pragma unroll
        for (int q = 0; q < 2; ++q) { const float s2 = rsqrtf(ss[q] * (1.f / 1024.f) + 1e-6f);
            if (q == 0 || hasB) {
#pragma unroll
                for (int i = 0; i < 4; ++i) { const f32x4 t = xv[q][i] * s2 * g2[i]; u32x2 w; w.x = pk2(t.x, t.y); w.y = pk2(t.z, t.w); *(u32x2*)(HN + (size_t)rows[q] * 1024 + lane * 4 + 256 * i) = w; } } }
    }
    for (int row = MP + bid * 8 + wid; row < MPAD; row += nb * 8) {
        bf16_t* o = HN + (size_t)row * 1024;
        if (row >= MT) { for (int i = 0; i < 4; ++i) *(u32x2*)(o + lane * 4 + 256 * i) = (u32x2){0u, 0u}; continue; }
        const float* x = row < MP ? P.in[I_XP] + (size_t)row * 1024 : P.in[I_XS] + (size_t)(row - MP) * 1024;
        float* x1o = P.out + (size_t)row * 1024;
        f32x4 mx[4]; float sc;
        if (row < MP) {
#pragma unroll
            for (int i = 0; i < 4; ++i) { const u32x2 mb = *(const u32x2*)(MIX + (size_t)row * 1024 + lane * 4 + 256 * i); mx[i] = (f32x4){bflo(mb.x), bfhi(mb.x), bflo(mb.y), bfhi(mb.y)}; }
            sc = rsqrtf(rss[row] * (1.f / 1024.f) + 1e-6f);
        } else {
            const float* ms = (const float*)(P.ws + MIXS_O) + (size_t)(row - MP) * 1024; float s0 = 0.f;
#pragma unroll
            for (int i = 0; i < 4; ++i) { mx[i] = *(const f32x4*)(ms + lane * 4 + 256 * i); s0 += mx[i].x * mx[i].x + mx[i].y * mx[i].y + mx[i].z * mx[i].z + mx[i].w * mx[i].w; }
            sc = rsqrtf(wave_sum(s0) * (1.f / 1024.f) + 1e-6f);
        }
        f32x4 v[4]; float ss = 0.f;
#pragma unroll
        for (int i = 0; i < 4; ++i) {
            const int c = lane * 4 + 256 * i;
            const f32x4 xv = *(const f32x4*)(x + c), g = *(const f32x4*)(P.in[I_NPOM] + c);
            v[i] = xv + mx[i] * sc * g;
            *(f32x4*)(x1o + c) = v[i];
            ss += v[i].x * v[i].x + v[i].y * v[i].y + v[i].z * v[i].z + v[i].w * v[i].w;
        }
        ss = wave_sum(ss);
        const float s2 = rsqrtf(ss * (1.f / 1024.f) + 1e-6f);
#pragma unroll
        for (int i = 0; i < 4; ++i) { const int c = lane * 4 + 256 * i; const f32x4 g = *(const f32x4*)(P.in[I_NPF] + c);
            u32x2 w; w.x = pk2(v[i].x * s2 * g.x, v[i].y * s2 * g.y); w.y = pk2(v[i].z * s2 * g.z, v[i].w * s2 * g.w); *(u32x2*)(o + c) = w; }
    }
}

__device__ void phase_f2(const Params& P, int bid, int nb) {
    const float* STASH = (const float*)(P.ws + STASH_O);
    bf16_t* ACT = wsbw(P, ACT_O);
    const float* cw = P.in[I_FCW]; const float* cbias = P.in[I_FCB];
    for (int idx = bid * 512 + TID(); idx < 256 * 2 * 704; idx += nb * 512) {
        const int c = (idx % 704) * 4, q = idx / 704, rr = q & 1, g = q >> 1, row = g * 64 + rr;
        const bool first = (g & 31) == 0;
        const float* sc = STASH + (size_t)g * 4 * DFF2; const float* spv = sc - 4 * DFF2;
        f32x4 a;
#pragma unroll
        for (int half = 0; half < 2; ++half) {
            const int cc = c + half * DFF;
            const f32x4 z = (f32x4){0.f, 0.f, 0.f, 0.f};
            f32x4 x0, x1, x2;
            if (rr == 0) { x0 = __builtin_nontemporal_load((const f32x4*)(sc + cc)); x1 = first ? z : __builtin_nontemporal_load((const f32x4*)(spv + 3 * DFF2 + cc)); x2 = first ? z : __builtin_nontemporal_load((const f32x4*)(spv + 2 * DFF2 + cc)); }
            else { x0 = __builtin_nontemporal_load((const f32x4*)(sc + DFF2 + cc)); x1 = __builtin_nontemporal_load((const f32x4*)(sc + cc)); x2 = first ? z : __builtin_nontemporal_load((const f32x4*)(spv + 3 * DFF2 + cc)); }
            const f32x4 w0 = *(const f32x4*)(cw + cc), w1 = *(const f32x4*)(cw + DFF2 + cc), w2 = *(const f32x4*)(cw + 2 * DFF2 + cc), bb = *(const f32x4*)(cbias + cc);
            const f32x4 uu = bb + w0 * x2 + w1 * x1 + w2 * x0;
            if (half == 0) { a.x = gelu_t(uu.x); a.y = gelu_t(uu.y); a.z = gelu_t(uu.z); a.w = gelu_t(uu.w); }
            else a = a * uu;
        }
        u32x2 w; w.x = pk2(a.x, a.y); w.y = pk2(a.z, a.w);
        *(u32x2*)(ACT + (size_t)row * DFF + c) = w;
    }
    { const float* SUP = (const float*)(P.ws + SUP_O);
      for (int idx = bid * 512 + TID(); idx < 256 * 704; idx += nb * 512) {
        const int c = (idx % 704) * 4, b = idx / 704;
        if (b >= 128) { *(u32x2*)(ACT + (size_t)(MP + b) * DFF + c) = (u32x2){0u, 0u}; continue; }
        const float* st = P.in[I_SFCONV] + (size_t)b * 2 * DFF2; float* so = P.out + O_SFCONV + (size_t)b * 2 * DFF2;
        f32x4 a;
#pragma unroll
        for (int half = 0; half < 2; ++half) {
            const int cc = c + half * DFF;
            const f32x4 x0 = *(const f32x4*)(SUP + (size_t)b * DFF2 + cc), x1 = *(const f32x4*)(st + DFF2 + cc), x2 = *(const f32x4*)(st + cc);
            const f32x4 w0 = *(const f32x4*)(cw + cc), w1 = *(const f32x4*)(cw + DFF2 + cc), w2 = *(const f32x4*)(cw + 2 * DFF2 + cc), bb = *(const f32x4*)(cbias + cc);
            const f32x4 uu = bb + w0 * x2 + w1 * x1 + w2 * x0;
            if (half == 0) { a.x = gelu_t(uu.x); a.y = gelu_t(uu.y); a.z = gelu_t(uu.z); a.w = gelu_t(uu.w); }
            else a = a * uu;
            *(f32x4*)(so + cc) = x1; *(f32x4*)(so + DFF2 + cc) = x0;
        }
        u32x2 w; w.x = pk2(a.x, a.y); w.y = pk2(a.z, a.w);
        *(u32x2*)(ACT + (size_t)(MP + b) * DFF + c) = w;
      } }
    for (int idx = bid * 512 + TID(); idx < 8 * 2 * 1408; idx += nb * 512) {
        const int c = (idx % 1408) * 4, q = idx / 1408, j = q & 1, b = q >> 1;
        *(f32x4*)(P.out + O_PFCONV + ((size_t)b * 2 + j) * DFF2 + c) = *(const f32x4*)(STASH + ((size_t)(b * 32 + 31) * 4 + 2 + j) * DFF2 + c);
    }
}

__device__ void phase_h(const Params& P, int bid, int nb) {
    const int tid = TID(), wid = tid >> 6, lane = tid & 63;
    const bf16_t* F = wsb(P, F_O); const float* rss = (const float*)(P.ws + ROWSS2);
    const bf16_t* MIX = wsb(P, MIX_O); const float* rss1 = (const float*)(P.ws + ROWSS1);
    for (int rowA = bid * 8 + wid; rowA < MP; rowA += nb * 16) {
        const int rowB = rowA + nb * 8; const bool hasB = rowB < MP; const int rows[2] = {rowA, hasB ? rowB : rowA};
        f32x4 xv[2][4]; u32x2 fb[2][4], mb[2][4]; float rs[2], rs1[2];
#pragma unroll
        for (int q = 0; q < 2; ++q) { rs[q] = rss[rows[q]]; rs1[q] = rss1[rows[q]];
#pragma unroll
            for (int i = 0; i < 4; ++i) { const int c = lane * 4 + 256 * i; xv[q][i] = __builtin_nontemporal_load((const f32x4*)(P.in[I_XP] + (size_t)rows[q] * 1024 + c));
                fb[q][i] = __builtin_nontemporal_load((const u32x2*)(F + (size_t)rows[q] * 1024 + c)); mb[q][i] = __builtin_nontemporal_load((const u32x2*)(MIX + (size_t)rows[q] * 1024 + c)); } }
#pragma unroll
        for (int q = 0; q < 2; ++q) { const float sc = rsqrtf(rs[q] * (1.f / 1024.f) + 1e-6f), sc1 = rsqrtf(rs1[q] * (1.f / 1024.f) + 1e-6f);
            if (q == 0 || hasB) {
#pragma unroll
                for (int i = 0; i < 4; ++i) { const f32x4 g = *(const f32x4*)(P.in[I_NPOF] + lane * 4 + 256 * i), g1 = *(const f32x4*)(P.in[I_NPOM] + lane * 4 + 256 * i);
                    const f32x4 f = (f32x4){bflo(fb[q][i].x), bfhi(fb[q][i].x), bflo(fb[q][i].y), bfhi(fb[q][i].y)};
                    const f32x4 m = (f32x4){bflo(mb[q][i].x), bfhi(mb[q][i].x), bflo(mb[q][i].y), bfhi(mb[q][i].y)};
                    *(f32x4*)(P.out + (size_t)rows[q] * 1024 + lane * 4 + 256 * i) = (xv[q][i] + m * sc1 * g1) + f * sc * g; } } }
    }
    for (int row = MP + bid * 8 + wid; row < MT; row += nb * 8) {
        float* xo = P.out + (size_t)row * 1024;
        f32x4 fx[4]; float sc;
        if (row < MP) {
#pragma unroll
            for (int i = 0; i < 4; ++i) { const u32x2 fb = *(const u32x2*)(F + (size_t)row * 1024 + lane * 4 + 256 * i); fx[i] = (f32x4){bflo(fb.x), bfhi(fb.x), bflo(fb.y), bfhi(fb.y)}; }
            sc = rsqrtf(rss[row] * (1.f / 1024.f) + 1e-6f);
        } else {
            const float* fs = (const float*)(P.ws + FS_O) + (size_t)(row - MP) * 1024; float s0 = 0.f;
#pragma unroll
            for (int i = 0; i < 4; ++i) { fx[i] = *(const f32x4*)(fs + lane * 4 + 256 * i); s0 += fx[i].x * fx[i].x + fx[i].y * fx[i].y + fx[i].z * fx[i].z + fx[i].w * fx[i].w; }
            sc = rsqrtf(wave_sum(s0) * (1.f / 1024.f) + 1e-6f);
        }
#pragma unroll
        for (int i = 0; i < 4; ++i) {
            const int c = lane * 4 + 256 * i;
            f32x4 xv = *(const f32x4*)(xo + c); const f32x4 g = *(const f32x4*)(P.in[I_NPOF] + c);
            xv = xv + fx[i] * sc * g;
            *(f32x4*)(xo + c) = xv;
        }
    }
}

template <int NST, int NP, class Epi>
__device__ __forceinline__ void sample_gemm(LAS unsigned char* ldsb, int bid, int nb, const bf16_t* A0, const bf16_t* Bt0, const bf16_t* A1, const bf16_t* Bt1, const Epi& epi) {
    constexpr int K = NST * 32 * 8;
    const int tid = TID(), wid = tid >> 6, lane = tid & 63, fr = lane & 15, fq = lane >> 4;
    LAS float* red = (LAS float*)ldsb;
    for (int it = bid; it < 256; it += nb) {
        const int row0 = 32 * (it & 3), col0 = 16 * (it >> 2), kb = wid * (K / 8) + fq * 8;
        f32x4 acc[NP][2];
#pragma unroll
        for (int p = 0; p < NP; ++p) {
            acc[p][0] = (f32x4){0.f, 0.f, 0.f, 0.f}; acc[p][1] = acc[p][0];
            const bf16_t* Ap = (p ? A1 : A0) + (size_t)(MP + row0 + fr) * K + kb;
            const bf16_t* Bp = (p ? Bt1 : Bt0) + (size_t)(col0 + fr) * K + kb;
            bf16x8 a0[NST], a1[NST], bb[NST];
#pragma unroll
            for (int s_ = 0; s_ < NST; ++s_) { a0[s_] = *(const bf16x8*)(Ap + s_ * 32); a1[s_] = *(const bf16x8*)(Ap + (size_t)16 * K + s_ * 32); bb[s_] = *(const bf16x8*)(Bp + s_ * 32); }
#pragma unroll
            for (int s_ = 0; s_ < NST; ++s_) { acc[p][0] = __builtin_amdgcn_mfma_f32_16x16x32_bf16(a0[s_], bb[s_], acc[p][0], 0, 0, 0); acc[p][1] = __builtin_amdgcn_mfma_f32_16x16x32_bf16(a1[s_], bb[s_], acc[p][1], 0, 0, 0); }
        }
#pragma unroll
        for (int p = 0; p < NP; ++p)
#pragma unroll
            for (int t = 0; t < 2; ++t) *(LAS f32x4*)(red + ((((wid * NP + p) * 2 + t) * 64) + lane) * 4) = acc[p][t];
        __syncthreads();
        if (wid < 2) {
            f32x4 r[NP];
#pragma unroll
            for (int p = 0; p < NP; ++p) { r[p] = (f32x4){0.f, 0.f, 0.f, 0.f};
#pragma unroll
                for (int w = 0; w < 8; ++w) r[p] += *(const LAS f32x4*)(red + ((((w * NP + p) * 2 + wid) * 64) + lane) * 4); }
#pragma unroll
            for (int i = 0; i < 4; ++i) epi(r, i, row0 + 16 * wid + fq * 4 + i, col0 + fr);
        }
        __syncthreads();
    }
}

#define XB_TMO      128
#define XB_XCNT(j)  (256  + 64 * (j))
#define XB_XSUB(j)  (1280 + 64 * (j))
#define XB_XGEN(j)  (2304 + 64 * (j))
#define XB_TOP      3328
#define XB_TOPGEN   3392
#define XCD_BAR_WORDS 3456
#define XB_SPIN_CAP (1u << 18)
__device__ __forceinline__ unsigned xb_ld(unsigned* p)              { return __hip_atomic_load(p, __ATOMIC_RELAXED, __HIP_MEMORY_SCOPE_AGENT); }
__device__ __forceinline__ unsigned xb_add(unsigned* p, unsigned v) { return __hip_atomic_fetch_add(p, v, __ATOMIC_RELAXED, __HIP_MEMORY_SCOPE_AGENT); }
__device__ __forceinline__ unsigned xb_xcc_id() { return (unsigned)__builtin_amdgcn_s_getreg((3 << 11) | 20) & 0xFu; }
#define XB_SPIN(cond, bar) do { unsigned _sp = 0; while (cond) { __builtin_amdgcn_s_sleep(1); \
    if ((++_sp & 255u) == 0u) { if (xb_ld(&(bar)[XB_TMO])) break; if (_sp > XB_SPIN_CAP) { atomicAdd(&(bar)[XB_TMO], 1u); break; } } } } while (0)
struct XcdBarrier { unsigned* bar; unsigned x; volatile LAS unsigned* st; };
__device__ __forceinline__ XcdBarrier xcd_barrier_post(unsigned* bar, volatile LAS unsigned* st) {
    XcdBarrier b; b.bar = bar; b.x = xb_xcc_id(); b.st = st;
    if (threadIdx.x == 0) (void)xb_add(&bar[XB_XCNT(b.x)], 1u);
    return b;
}
__device__ __forceinline__ void xcd_barrier_complete(unsigned* bar, unsigned x, unsigned& nloc, unsigned& nx) {
    const unsigned G = gridDim.x * gridDim.y * gridDim.z;
    unsigned sum, cnt, mine, sp = 0u;
    for (;;) {
        sum = 0u; cnt = 0u; mine = 0u;
#pragma unroll
        for (unsigned j = 0; j < 16; ++j) { const unsigned c = xb_ld(&bar[XB_XCNT(j)]); sum += c; cnt += (c > 0u) ? 1u : 0u; mine = (j == x) ? c : mine; }
        if (sum == G) break;
        __builtin_amdgcn_s_sleep(1);
        if ((++sp & 255u) == 0u) { if (xb_ld(&bar[XB_TMO])) break; if (sp > XB_SPIN_CAP) { atomicAdd(&bar[XB_TMO], 1u); break; } }
    }
    nloc = mine > 0u ? mine : 1u; nx = cnt > 0u ? cnt : 1u;
}
__device__ __forceinline__ void xcd_barrier(const XcdBarrier& b) {
    asm volatile("s_waitcnt vmcnt(0)" ::: "memory");
    __syncthreads();
    if (TID() == 0) {
        unsigned* bar = b.bar;
        __builtin_amdgcn_s_waitcnt(0);
        unsigned nloc = b.st[0], nx = b.st[1];
        if (nloc == 0u) { xcd_barrier_complete(bar, b.x, nloc, nx); b.st[0] = nloc; b.st[1] = nx; }
        const unsigned old = xb_add(&bar[XB_XSUB(b.x)], 1u);
        const unsigned gen = old / nloc;
        if (old + 1u == (gen + 1u) * nloc) {
            __builtin_amdgcn_fence(__ATOMIC_RELEASE, "agent");
            asm volatile("s_waitcnt vmcnt(0)" ::: "memory");
            const unsigned og = xb_add(&bar[XB_TOP], 1u);
            const unsigned tg = og / nx;
            if (og + 1u == (tg + 1u) * nx) xb_add(&bar[XB_TOPGEN], 1u);
            else XB_SPIN(xb_ld(&bar[XB_TOPGEN]) == tg, bar);
            __builtin_amdgcn_fence(__ATOMIC_ACQUIRE, "agent");
            xb_add(&bar[XB_XGEN(b.x)], 1u);
            asm volatile("s_waitcnt vmcnt(0)" ::: "memory");
        } else {
            XB_SPIN(xb_ld(&bar[XB_XGEN(b.x)]) == gen, bar);
            __builtin_amdgcn_fence(__ATOMIC_ACQUIRE, "agent");
            asm volatile("s_waitcnt vmcnt(0)" ::: "memory");
        }
    }
    __syncthreads();
}

constexpr int NPHASE = 13;
__device__ __forceinline__ void run_phase(const Params& P, const int ph, LAS unsigned char* lds, int bid, int nb) {
    asm volatile("" : "+s"(bid), "+s"(nb));
    Sched S;
#ifdef PROBE_TS
#define TSACC(S_) (S_).tsacc = (unsigned long long*)(P.ws + TS_O) + 48 + ph
#else
#define TSACC(S_) do { } while (0)
#endif
    switch (ph) {
    case 0: phase0(P, lds, bid, nb); break;
    case 1: { S.init(P.ws + XN_O, P.ws + W_IN_T, nullptr, nullptr, MPAD, INC, 1024, nb, bid, 0); TSACC(S); EpiStore E{wsbw(P, PROJ_O), INC, nullptr}; gemm_phase(lds, S, 1024, E); } break;
    case 2: phase_b0(P, bid, nb); break;
    case 3: { S.init((unsigned char*)P.out + LA_O, P.ws + W_LORA_T, nullptr, nullptr, MPAD, 1536, 256, nb, bid, 0); TSACC(S); EpiLora E{&P}; gemm_phase(lds, S, 256, E);
              S.init((unsigned char*)P.out + XC_O, P.ws + W_LRUG_T, nullptr, nullptr, MPAD, 1024, 512, nb, (bid + nb / 2 - 8) % nb, 0); TSACC(S); EpiLru E2{&P}; gemm_phase(lds, S, 512, E2); } break;
    case 4: if (nb == 256) { wkv_scan<true>(P, bid, (LAS float*)lds, bid, nb); __syncthreads(); }
            else { const int t_ = TID(); sample_wkv(P, bid * 8 + (t_ >> 6), nb * 8); sample_lru(P, bid * 512 + t_, nb * 512); lru_pass1(P, bid * 512 + t_, nb * 512);
                   for (int it = bid; it < 256; it += nb) { wkv_scan<false>(P, it, (LAS float*)lds, bid, nb); __syncthreads(); } }
            break;
    case 5: lru_pass2(P, bid, nb); phase_za(P, bid, nb); break;
    case 6: { { const bf16_t* proj = wsb(P, PROJ_O); bf16_t* O = wsbw(P, MIXIN_O);
                auto epi = [&](const f32x4 (&r)[2], int i, int row, int col) { const bf16_t* gp = proj + (size_t)(MP + row) * INC + 2304 + col;
                    O[(size_t)(MP + row) * 1024 + col] = f2bf(sigm(bf1(gp[0])) * r[0][i] + sigm(bf1(gp[1024])) * r[1][i]); };
                sample_gemm<2, 2>(lds, bid, nb, outb(P, ZA_O), wsb(P, W_A_T), outb(P, HS_O), wsb(P, W_B_T), epi); }
              S.init((unsigned char*)P.out + ZA_O, P.ws + W_A_T, (unsigned char*)P.out + HS_O, P.ws + W_B_T, MP, 1024, 512, nb, bid, 1); TSACC(S); EpiMix E{&P}; gemm_phase(lds, S, 512, E); } break;
    case 7: { { float* O = (float*)(P.ws + MIXS_O); auto epi = [&](const f32x4 (&r)[1], int i, int row, int col) { O[(size_t)row * 1024 + col] = r[0][i]; };
                sample_gemm<4, 1>(lds, bid, nb, wsb(P, MIXIN_O), wsb(P, W_O_T), nullptr, nullptr, epi); }
              S.init(P.ws + MIXIN_O, P.ws + W_O_T, nullptr, nullptr, MP, 1024, 1024, nb, bid, 0); TSACC(S); EpiStore E{wsbw(P, MIX_O), 1024, (float*)(P.ws + ROWSS1)}; gemm_phase(lds, S, 1024, E); } break;
    case 8: phase_e(P, bid, nb); break;
    case 9: { S.init(P.ws + HN_O, P.ws + W_UP_T, nullptr, nullptr, MPAD, DFF2, 1024, nb, bid, 0); TSACC(S); EpiUp E{&P}; gemm_phase(lds, S, 1024, E); } break;
    case 10: phase_f2(P, bid, nb); break;
    case 11: { { float* O = (float*)(P.ws + FS_O); auto epi = [&](const f32x4 (&r)[1], int i, int row, int col) { O[(size_t)row * 1024 + col] = r[0][i]; };
                 sample_gemm<11, 1>(lds, bid, nb, wsb(P, ACT_O), wsb(P, W_DN_T), nullptr, nullptr, epi); }
               S.init(P.ws + ACT_O, P.ws + W_DN_T, nullptr, nullptr, MP, 1024, DFF, nb, bid, 0); TSACC(S); EpiStore E{wsbw(P, F_O), 1024, (float*)(P.ws + ROWSS2)}; gemm_phase(lds, S, DFF, E); } break;
    case 12: phase_h(P, bid, nb); break;
    }
}

template <int PH0, int PH1>
__global__ void __launch_bounds__(512, 2) mega(Params P) {
    extern __shared__ __attribute__((aligned(16))) unsigned char shm[];
    LAS unsigned char* lds = (LAS unsigned char*)shm;
    cg::grid_group grid = cg::this_grid();
    volatile LAS unsigned* xbst = (volatile LAS unsigned*)(lds + 131072);
    if (threadIdx.x == 0) { xbst[0] = 0u; xbst[1] = 0u; }
    __syncthreads();
    const XcdBarrier xb = xcd_barrier_post((unsigned*)(P.ws + BAR_O), xbst);
    if (gridDim.y == 0x7fffffffu) grid.sync();
#define MK_PHASE(ph) do { if constexpr ((ph) >= PH0 && (ph) < PH1) { \
          \
        const __attribute__((address_space(4))) Params* kp = (const __attribute__((address_space(4))) Params*)__builtin_amdgcn_kernarg_segment_ptr(); \
        asm volatile("" : "+s"(kp)); \
        if ((ph) == 0) { if (blockIdx.x == 0 && threadIdx.x < 64) ((unsigned long long*)(kp->ws + TS_O))[threadIdx.x] = 0ull; __syncthreads(); MARK(*kp, 0); } \
        run_phase(*(const Params*)kp, (ph), lds, blockIdx.x, gridDim.x); MARK(*kp, 2 * (ph) + 1); \
        if constexpr ((ph) + 1 < PH1) { xcd_barrier(xb); MARK(*kp, 2 * (ph) + 2); } } } while (0)
#ifdef DUP_PHASE
#define MK_DUP(ph) do { if constexpr ((ph) == DUP_PHASE) { const __attribute__((address_space(4))) Params* kp = (const __attribute__((address_space(4))) Params*)__builtin_amdgcn_kernarg_segment_ptr(); \
        asm volatile("" : "+s"(kp)); run_phase(*(const Params*)kp, (ph), lds, blockIdx.x, gridDim.x); grid.sync(); } } while (0)
#else
#define MK_DUP(ph) do { } while (0)
#endif
    MK_DUP(0); MK_PHASE(0); MK_DUP(1); MK_PHASE(1); MK_DUP(2); MK_PHASE(2); MK_DUP(3); MK_PHASE(3); MK_DUP(4); MK_PHASE(4); MK_PHASE(5); MK_DUP(6); MK_PHASE(6);
    MK_PHASE(7); MK_DUP(8); MK_PHASE(8); MK_DUP(9); MK_PHASE(9); MK_DUP(10); MK_PHASE(10); MK_PHASE(11); MK_PHASE(12);
#undef MK_PHASE
#ifdef PROBE_TS
    if (blockIdx.x == 0 && threadIdx.x == 0) {
        const unsigned long long* ts = (const unsigned long long*)(P.ws + TS_O);
        auto val = [&](int a, int b) -> unsigned long long { unsigned long long v = (a >= 48) ? ts[a] : ts[b] - ts[a]; v /= (unsigned long long)PQ; return v > 63ull ? 63ull : v; };
        const unsigned long long w = 2000ull * val(PSEL1A, PSEL1B) + 128000ull * val(PSEL2A, PSEL2B);
        const unsigned long long t0 = __builtin_amdgcn_s_memrealtime();
        while (__builtin_amdgcn_s_memrealtime() - t0 < w) __builtin_amdgcn_s_sleep(8);
    }
#endif
}

template <int PH0, int PH1>
static void launch_range(const Params& p, hipStream_t stream) {
    static int grid_blocks = 0;
    const void* fn = (const void*)mega<PH0, PH1>;
    if (!grid_blocks) {
        (void)hipFuncSetAttribute(fn, hipFuncAttributeMaxDynamicSharedMemorySize, LDS_BYTES);
        int dev = 0, cus = 0, per_cu = 0;
        (void)hipGetDevice(&dev);
        (void)hipDeviceGetAttribute(&cus, hipDeviceAttributeMultiprocessorCount, dev);
        (void)hipOccupancyMaxActiveBlocksPerMultiprocessor(&per_cu, mega<PH0, PH1>, 512, LDS_BYTES);
        if (per_cu != 1) fprintf(stderr, "note: occupancy query says %d blocks/CU; using 1\n", per_cu);
        grid_blocks = cus;
        if (per_cu < 1) grid_blocks = 0;
    }
    if (!grid_blocks) { fprintf(stderr, "kernel not launchable\n"); return; }
    Params pl = p;
    void* args[] = {&pl};
    hipError_t e = hipLaunchCooperativeKernel(fn, dim3(grid_blocks), dim3(512), args, LDS_BYTES, stream);
    if (e != hipSuccess) fprintf(stderr, "cooperative launch failed: %s (grid %d)\n", hipGetErrorString(e), grid_blocks);
}

extern "C" void kernel_launch(void* const* d_in, const int* in_sizes, int n_in, void* d_out, int out_size, void* d_ws, size_t ws_size, hipStream_t stream) {
    if (ws_size < WS_NEED) { fprintf(stderr, "workspace too small: %zu < %zu\n", ws_size, (size_t)WS_NEED); return; }
    Params p{};
    for (int i = 0; i < 37; ++i) p.in[i] = (const float*)d_in[i];
    p.out = (float*)d_out; p.ws = (unsigned char*)d_ws;
    (void)hipMemsetAsync((unsigned char*)d_ws + BAR_O, 0, XCD_BAR_WORDS * sizeof(unsigned), stream);
#if ONE_LAUNCH
    launch_range<0, NPHASE>(p, stream);
#else
    launch_range<0, 1>(p, stream); launch_range<1, 2>(p, stream); launch_range<2, 3>(p, stream); launch_range<3, 4>(p, stream);
    launch_range<4, 5>(p, stream); launch_range<5, 6>(p, stream); launch_range<6, 7>(p, stream); launch_range<7, 8>(p, stream);
    launch_range<8, 9>(p, stream); launch_range<9, 10>(p, stream); launch_range<10, 11>(p, stream); launch_range<11, 12>(p, stream);
    launch_range<12, 13>(p, stream);
#endif
}
```

```cpp
#include <hip/hip_runtime.h>
#include <hip/hip_cooperative_groups.h>
#include <cstdio>
namespace cg = cooperative_groups;

#ifndef ONE_LAUNCH
#define ONE_LAUNCH 1
#endif

#define LAS __attribute__((address_space(3)))
typedef unsigned short bf16_t;
typedef short bf16x8 __attribute__((ext_vector_type(8)));
typedef float f32x4 __attribute__((ext_vector_type(4)));
typedef unsigned u32x4 __attribute__((ext_vector_type(4)));
typedef unsigned u32x2 __attribute__((ext_vector_type(2)));

constexpr int MP = 16384, MT = 16512, MPAD = 16640;
constexpr int DM = 1024, RP = 1792, LW = 512, INC = 4352, DFF = 2816, DFF2 = 5632;
constexpr size_t O_YP = 0, O_YS = 16777216, O_PSHIFT = 16908288, O_PWKV = 16922624, O_PLCONV = 17184768, O_PLH = 17197056,
                 O_PFCONV = 17201152, O_SSHIFT = 17291264, O_SWKV = 17520640, O_SLCONV = 21714944, O_SLH = 21911552, O_SFCONV = 21977088;
constexpr size_t W_IN_T = 0, W_UP_T = 8912896, W_DN_T = 20447232, W_O_T = 26214400, W_A_T = 28311552, W_B_T = 29360128,
                 W_LRUG_T = 30408704, W_LORA_T = 31457280, ROWSS1 = 32243712, ROWSS2 = 32310272;
constexpr size_t BASE1 = 33554432;
constexpr size_t PROJ_O = BASE1;
constexpr size_t R2 = BASE1 + 144834560;
constexpr size_t SZ512 = (size_t)MPAD * 512 * 2;
constexpr size_t SZ1024 = (size_t)MPAD * 1024 * 2;
constexpr size_t XN_O = R2, KK_O = R2, E_O = R2 + SZ512, ASIG_O = R2 + 2 * SZ512, G_O = R2 + 3 * SZ512, Y_O = R2 + 4 * SZ512;
constexpr size_t MIXIN_O = R2, MIX_O = BASE1, HN_O = R2 + SZ1024, ACT_O = BASE1 + SZ1024, STASH_O = ACT_O + (size_t)MPAD * DFF * 2, F_O = R2;
constexpr size_t CARRY_P = R2 + 5 * SZ512, CARRY_H = CARRY_P + 1048576, TS_O = CARRY_H + 1048576;
constexpr size_t BAR_O = TS_O + 1024;
constexpr size_t MIXS_O = BAR_O + 16384, FS_O = MIXS_O + 524288;
constexpr size_t BON_O = FS_O + 524288;
constexpr size_t WS_NEED = BON_O + (size_t)MT * 8 * 4;
static_assert(WS_NEED <= 268435456ull, "ws too big");
constexpr size_t SUP_O = STASH_O + 260ull * 4 * DFF2 * 4;
static_assert(SUP_O + 128ull * DFF2 * 4 <= HN_O, "stash overlaps hn");
constexpr size_t LA_O = 0, XC_O = 8519680, LLA_O = XC_O + SZ512, LU_O = LLA_O + SZ512;
constexpr size_t ZA_O = XC_O, HS_O = LU_O;
static_assert(LU_O + SZ512 <= (size_t)MT * 1024 * 4, "d_out scratch too big");

constexpr int LDS_BYTES = 131072 + 64;

struct Params {
    const float* in[37];
    float* out;
    unsigned char* ws;
};
enum { I_XP = 0, I_XS, I_SSHIFT, I_SWKV, I_SLCONV, I_SLH, I_SFCONV, I_NPM, I_NPOM, I_NPF, I_NPOF, I_WIN, I_MU, I_W0, I_WUP, I_A0, I_AUP, I_GUP,
       I_KK, I_KA, I_RK, I_LNW, I_LNB, I_WOUT, I_LCW, I_LCB, I_GXW, I_GXB, I_GAW, I_GAB, I_LAM, I_LWOUT, I_WO, I_FUP, I_FCW, I_FCB, I_FDN };

__device__ __forceinline__ int TID() { int t = threadIdx.x; asm volatile("" : "+v"(t)); return t; }
__device__ __forceinline__ float bflo(unsigned u) { return __uint_as_float(u << 16); }
__device__ __forceinline__ float bfhi(unsigned u) { return __uint_as_float(u & 0xffff0000u); }
__device__ __forceinline__ float bf1(bf16_t b) { return __uint_as_float(((unsigned)b) << 16); }
__device__ __forceinline__ unsigned pk2(float lo, float hi) { unsigned r; asm volatile("v_cvt_pk_bf16_f32 %0, %1, %2" : "=v"(r) : "v"(lo), "v"(hi)); return r; }
__device__ __forceinline__ bf16_t f2bf(float f) { return (bf16_t)(pk2(f, 0.f) & 0xffffu); }
__device__ __forceinline__ void unpack8(const u32x4 u, float (&o)[8]) {
    o[0] = bflo(u.x); o[1] = bfhi(u.x); o[2] = bflo(u.y); o[3] = bfhi(u.y); o[4] = bflo(u.z); o[5] = bfhi(u.z); o[6] = bflo(u.w); o[7] = bfhi(u.w);
}
__device__ __forceinline__ u32x4 pack8(const float (&v)[8]) { u32x4 w; w.x = pk2(v[0], v[1]); w.y = pk2(v[2], v[3]); w.z = pk2(v[4], v[5]); w.w = pk2(v[6], v[7]); return w; }
__device__ __forceinline__ void ld8bf(const bf16_t* p, float (&o)[8]) { unpack8(*(const u32x4*)p, o); }
__device__ __forceinline__ void ld8bf_nt(const bf16_t* p, float (&o)[8]) { unpack8(__builtin_nontemporal_load((const u32x4*)p), o); }
__device__ __forceinline__ void ld8f(const float* p, float (&o)[8]) { const f32x4 a = *(const f32x4*)p, b = *(const f32x4*)(p + 4); o[0] = a.x; o[1] = a.y; o[2] = a.z; o[3] = a.w; o[4] = b.x; o[5] = b.y; o[6] = b.z; o[7] = b.w; }
__device__ __forceinline__ void st8f(float* p, const float (&v)[8]) { *(f32x4*)p = (f32x4){v[0], v[1], v[2], v[3]}; *(f32x4*)(p + 4) = (f32x4){v[4], v[5], v[6], v[7]}; }
__device__ __forceinline__ float rcp_(float x) { return __builtin_amdgcn_rcpf(x); }
__device__ __forceinline__ float sigm(float x) { return rcp_(1.f + __expf(-x)); }
__device__ __forceinline__ float tanh_(float x) { return 1.f - 2.f * rcp_(1.f + __expf(2.f * x)); }
__device__ __forceinline__ float fma_s(float a, float b, float c) { float r; asm("v_fma_f32 %0, %1, %2, %3" : "=v"(r) : "v"(a), "v"(b), "v"(c)); return r; }
__device__ __forceinline__ float gelu_t(float x) { const float p = fmaf(x * x, -0.10294324f, -2.30220819f);
    return x * rcp_(1.f + __builtin_amdgcn_exp2f(p * x)); }
__device__ __forceinline__ float wave_sum(float v) { for (int o = 32; o; o >>= 1) v += __shfl_xor(v, o); return v; }
template <int CTRL> __device__ __forceinline__ float dppf(float x) { return __int_as_float(__builtin_amdgcn_update_dpp(0, __float_as_int(x), CTRL, 0xF, 0xF, true)); }
__device__ __forceinline__ float row16_sum(float x) {
    x += dppf<0xB1>(x);
    x += dppf<0x4E>(x);
    x += dppf<0x141>(x);
    x += dppf<0x140>(x);
    return x;
}
#ifdef USE_BPERM
__device__ __forceinline__ float ror1(float x) { const int l = threadIdx.x & 63; return __shfl(x, (l & 48) | ((l - 1) & 15)); }
__device__ __forceinline__ float ror2(float x) { const int l = threadIdx.x & 63; return __shfl(x, (l & 48) | ((l - 2) & 15)); }
#else
__device__ __forceinline__ float ror1(float x) { return dppf<0x121>(x); }
__device__ __forceinline__ float ror2(float x) { return dppf<0x122>(x); }
#endif

__device__ __forceinline__ const bf16_t* wsb(const Params& P, size_t off) { return (const bf16_t*)(P.ws + off); }
__device__ __forceinline__ bf16_t* wsbw(const Params& P, size_t off) { return (bf16_t*)(P.ws + off); }
__device__ __forceinline__ bf16_t* outb(const Params& P, size_t off) { return (bf16_t*)((unsigned char*)P.out + off); }

__device__ __forceinline__ void shifted8(const Params& P, int row, int col, float (&m)[8]) {
    const bf16_t* proj = wsb(P, PROJ_O);
    float p[8], pv[8], mu[8];
    ld8bf(proj + (size_t)row * INC + col, p);
    if (row >= MP) ld8f(P.in[I_SSHIFT] + (size_t)(row - MP) * RP + col, pv);
    else if ((row & 2047) == 0) { for (int i = 0; i < 8; ++i) pv[i] = 0.f; }
    else ld8bf(proj + (size_t)(row - 1) * INC + col, pv);
    ld8f(P.in[I_MU] + col, mu);
#pragma unroll
    for (int i = 0; i < 8; ++i) m[i] = p[i] + mu[i] * (pv[i] - p[i]);
}
__device__ __forceinline__ float shifted1(const Params& P, int row, int col) {
    const bf16_t* proj = wsb(P, PROJ_O);
    const float p = bf1(proj[(size_t)row * INC + col]);
    float pv;
    if (row >= MP) pv = P.in[I_SSHIFT][(size_t)(row - MP) * RP + col];
    else if ((row & 2047) == 0) pv = 0.f;
    else pv = bf1(proj[(size_t)(row - 1) * INC + col]);
    return p + P.in[I_MU][col] * (pv - p);
}

#ifndef PQ
#define PQ 600
#endif
#ifdef PROBE_TS
#define MARK(P_, i_) do { if (blockIdx.x == 0 && threadIdx.x == 0) ((unsigned long long*)((P_).ws + TS_O))[(i_)] = __builtin_amdgcn_s_memrealtime(); } while (0)
#else
#define MARK(P_, i_) do { } while (0)
#endif
constexpr int BM = 256, BK = 64, HALF = 128, HTB = HALF * BK * 2, NXCD = 8, WGM = 8;
__device__ __forceinline__ int lds_byte(int r, int c) { const int st = (r >> 4) * 2 + (c >> 5), rr = r & 15, cc = c & 31, ob = rr * 64 + cc * 2; return st * 1024 + (ob ^ (((ob >> 9) & 1) << 5)); }
__device__ __forceinline__ void stage_rc(int b, int& R, int& C) { const int st = b / 1024, sb = b % 1024, swz = sb ^ (((sb >> 9) & 1) << 5); R = (st >> 1) * 16 + swz / 64; C = (st & 1) * 32 + (swz % 64) / 2; }
__device__ __forceinline__ int perm32(int rho) { const int n = rho >> 4, i = rho & 15; return 8 * (i >> 2) + 4 * n + (i & 3); }

struct Unit { int pm, pn, kind; };
struct Sched {
    const char* A0; const char* B0; const char* A1; const char* B1;
    __device__ __forceinline__ const char* pa(int kind) const { return kind ? A1 : A0; }
    __device__ __forceinline__ const char* pb(int kind) const { return kind ? B1 : B0; }
    unsigned long long* tsacc;
    int nM, nN, nwg, G, c, sshift;
    size_t tstep;
    __device__ __forceinline__ void init(const void* a0, const void* b0, const void* a1, const void* b1, int M, int N, int K, int G_, int c_, int ss) {
        A0 = (const char*)a0; B0 = (const char*)b0; A1 = (const char*)a1; B1 = (const char*)b1;
        nM = M / BM; nN = N / BM; nwg = nM * nN; G = G_; c = c_; sshift = ss; tstep = (size_t)BM * K * 2; tsacc = nullptr;
    }
    __device__ __forceinline__ bool next(int i, Unit& u) const {
        const int j = i >> sshift; u.kind = i - (j << sshift);
        const long L = (long)j * G + c; if (L >= nwg) return false;
        int wgid = (int)L; { const int q = nwg / NXCD, r = nwg % NXCD, xcd = wgid % NXCD, off = wgid / NXCD; wgid = (xcd < r ? xcd * (q + 1) : r * (q + 1) + (xcd - r) * q) + off; }
        const int nig = WGM * nN, gid = wgid / nig, fm = gid * WGM, gsz = (nM - fm) < WGM ? (nM - fm) : WGM;
        u.pm = fm + ((wgid % nig) % gsz); u.pn = (wgid % nig) / gsz; return true;
    }
};

template <class Epi>
__device__ __forceinline__ void gemm_phase(LAS unsigned char* lds, const Sched& S, const int K, const Epi& E) {
    const int tid = TID(), wid = __builtin_amdgcn_readfirstlane(tid >> 6), lane = tid & 63, wr = wid >> 2, wc = wid & 3, fr = lane & 15, fq = lane >> 4;
    const int nt = K / BK;
    unsigned voffA[2], voffB[2];
#pragma unroll
    for (int i = 0; i < 2; ++i) { int R, C; stage_rc(tid * 16 + i * 8192, R, C); const int Rb = (R & ~31) + perm32(R & 31);
        voffA[i] = (unsigned)(R * K + C) * 2u; voffB[i] = (unsigned)(Rb * K + C) * 2u; }
    const size_t kstep = (size_t)(BK * 2);
    const size_t hstep = (size_t)HALF * K * 2;
    const unsigned ldsw = (unsigned)wid * 1024u;
    const int aoff = lds_byte(wr * 64 + fr, fq * 8), boff = lds_byte(wc * 32 + fr, fq * 8);
#define PG8_SA(b, h) (((b) * 2 + (h)) * HTB)
#define PG8_SB(b, h) ((4 + (b) * 2 + (h)) * HTB)
#define PG8_STAGE(bufoff, gbase, voff) do { _Pragma("unroll") for (int _i = 0; _i < 2; ++_i) \
        __builtin_amdgcn_global_load_lds((const unsigned*)((const char*)(gbase) + (voff)[_i]), (LAS unsigned*)(lds + (bufoff) + ldsw + _i * 8192), 16, 0, 0); } while (0)
#define PG8_LDA(dst, b, h) do { _Pragma("unroll") for (int m = 0; m < 4; ++m) _Pragma("unroll") for (int k = 0; k < 2; ++k) dst[m][k] = *(const LAS bf16x8*)(lds + PG8_SA(b, h) + aoff + m * 2048 + k * 1024); } while (0)
#define PG8_LDB(dst, b, h) do { _Pragma("unroll") for (int n = 0; n < 2; ++n) _Pragma("unroll") for (int k = 0; k < 2; ++k) dst[n][k] = *(const LAS bf16x8*)(lds + PG8_SB(b, h) + boff + n * 2048 + k * 1024); } while (0)
#define PG8_MMA(ai, bj, At, Bt) do { __builtin_amdgcn_s_setprio(1); _Pragma("unroll") for (int m = 0; m < 4; ++m) _Pragma("unroll") for (int n = 0; n < 2; ++n) _Pragma("unroll") for (int k = 0; k < 2; ++k) \
        acc[ai][bj][m][n] = __builtin_amdgcn_mfma_f32_16x16x32_bf16(Bt[n][k], At[m][k], acc[ai][bj][m][n], 0, 0, 0); __builtin_amdgcn_s_setprio(0); } while (0)
#define PG8_WAIT_V(n) asm volatile("s_waitcnt vmcnt(" #n ")" ::: "memory")
#define PG8_WAIT_L(n) asm volatile("s_waitcnt lgkmcnt(" #n ")" ::: "memory")
#define PG8_BAR __builtin_amdgcn_s_barrier()
#define PG8_SCHED __builtin_amdgcn_sched_barrier(0)
    Unit cur, nxt; int ui = 0;
    if (!S.next(0, cur)) return;
#ifdef STAGGER_TICKS
    { const unsigned long long t0_ = __builtin_amdgcn_s_memrealtime(), dl_ = (unsigned long long)((S.c >> 3) & 3) * STAGGER_TICKS;
      while (__builtin_amdgcn_s_memrealtime() - t0_ < dl_) __builtin_amdgcn_s_sleep(4); }
#endif
    f32x4 acc[2][2][4][2];
#pragma unroll
    for (int a = 0; a < 2; ++a)
#pragma unroll
        for (int b = 0; b < 2; ++b)
#pragma unroll
            for (int m = 0; m < 4; ++m)
#pragma unroll
                for (int n = 0; n < 2; ++n) acc[a][b][m][n] = (f32x4){0.f, 0.f, 0.f, 0.f};
    bf16x8 At[4][2], B0[2][2], B1[2][2];
    const char* cA = S.pa(cur.kind) + (size_t)cur.pm * S.tstep; const char* cB = S.pb(cur.kind) + (size_t)cur.pn * S.tstep;
    PG8_STAGE(PG8_SB(0, 0), cB, voffB); PG8_STAGE(PG8_SA(0, 0), cA, voffA); PG8_STAGE(PG8_SB(0, 1), cB + hstep, voffB); PG8_STAGE(PG8_SA(0, 1), cA + hstep, voffA);
    if (wr == 1) PG8_BAR;
    PG8_WAIT_V(4); PG8_BAR;
    PG8_STAGE(PG8_SB(1, 0), cB + kstep, voffB); PG8_STAGE(PG8_SA(1, 0), cA + kstep, voffA); PG8_STAGE(PG8_SB(1, 1), cB + hstep + kstep, voffB);
    PG8_WAIT_V(6); PG8_BAR;
    for (;;) {
        const bool has_next = S.next(ui + 1, nxt);
        const char* nA = has_next ? S.pa(nxt.kind) + (size_t)nxt.pm * S.tstep : cA; const char* nB = has_next ? S.pb(nxt.kind) + (size_t)nxt.pn * S.tstep : cB;
        for (int t = 0; t < nt; t += 2) {
            const bool last = (t == nt - 2);
            const char* a1 = cA + (size_t)(t + 1) * kstep;
            const char* a2 = last ? nA : cA + (size_t)(t + 2) * kstep; const char* b2 = last ? nB : cB + (size_t)(t + 2) * kstep;
            const char* a3 = a2 + kstep; const char* b3 = b2 + kstep;
            PG8_LDB(B0, 0, 0); PG8_SCHED; PG8_LDA(At, 0, 0); PG8_STAGE(PG8_SA(1, 1), a1 + hstep, voffA);
            PG8_WAIT_L(8); PG8_BAR; PG8_WAIT_L(0); PG8_MMA(0, 0, At, B0); PG8_BAR; PG8_SCHED;
            PG8_LDB(B1, 0, 1); PG8_STAGE(PG8_SB(0, 0), b2, voffB);
            PG8_BAR; PG8_WAIT_L(0); PG8_MMA(0, 1, At, B1); PG8_BAR;
            PG8_LDA(At, 0, 1); PG8_STAGE(PG8_SA(0, 0), a2, voffA);
            PG8_BAR; PG8_WAIT_L(0); PG8_MMA(1, 0, At, B0); PG8_BAR; PG8_SCHED;
            PG8_STAGE(PG8_SB(0, 1), b2 + hstep, voffB);
            PG8_WAIT_V(6); PG8_BAR; PG8_MMA(1, 1, At, B1); PG8_BAR;
            PG8_LDB(B0, 1, 0); PG8_SCHED; PG8_LDA(At, 1, 0); PG8_STAGE(PG8_SA(0, 1), a2 + hstep, voffA);
            PG8_WAIT_L(8); PG8_BAR; PG8_WAIT_L(0); PG8_MMA(0, 0, At, B0); PG8_BAR; PG8_SCHED;
            PG8_LDB(B1, 1, 1); PG8_STAGE(PG8_SB(1, 0), b3, voffB);
            PG8_BAR; PG8_WAIT_L(0); PG8_MMA(0, 1, At, B1); PG8_BAR;
            PG8_LDA(At, 1, 1); PG8_STAGE(PG8_SA(1, 0), a3, voffA);
            PG8_BAR; PG8_WAIT_L(0); PG8_MMA(1, 0, At, B0); PG8_BAR; PG8_SCHED;
            PG8_STAGE(PG8_SB(1, 1), b3 + hstep, voffB);
            PG8_WAIT_V(6); PG8_BAR; PG8_MMA(1, 1, At, B1); PG8_BAR;
        }
#ifdef PROBE_EPI
        unsigned long long te0_ = 0; if (S.tsacc && blockIdx.x == 0 && threadIdx.x == 0) te0_ = __builtin_amdgcn_s_memrealtime();
#endif
        const bool keep = E(acc, cur, wr, wc, fr, fq);
#ifdef PROBE_EPI
        if (S.tsacc && blockIdx.x == 0 && threadIdx.x == 0) { asm volatile("s_waitcnt vmcnt(0)" ::: "memory"); *S.tsacc += __builtin_amdgcn_s_memrealtime() - te0_; }
#endif
        if (!has_next) break;
        if (!keep) {
#pragma unroll
            for (int a = 0; a < 2; ++a)
#pragma unroll
                for (int b = 0; b < 2; ++b)
#pragma unroll
                    for (int m = 0; m < 4; ++m)
#pragma unroll
                        for (int n = 0; n < 2; ++n) acc[a][b][m][n] = (f32x4){0.f, 0.f, 0.f, 0.f};
        }
        cur = nxt; cA = nA; cB = nB; ++ui;
    }
    PG8_WAIT_V(0);
    if (wr == 0) PG8_BAR;
    PG8_BAR;
#undef PG8_SA
#undef PG8_SB
#undef PG8_STAGE
#undef PG8_LDA
#undef PG8_LDB
#undef PG8_MMA
#undef PG8_WAIT_V
#undef PG8_WAIT_L
#undef PG8_BAR
#undef PG8_SCHED
}

typedef f32x4 Acc[2][2][4][2];

struct EpiStore {
    bf16_t* O; int ldc; float* rowss;
    __device__ __forceinline__ bool operator()(Acc& acc, const Unit& u, int wr, int wc, int fr_, int fq_) const {
        int fr = fr_, fq = fq_; asm volatile("" : "+v"(fr), "+v"(fq));
        const int row0 = u.pm * BM + wr * 64 + fr, col0 = u.pn * BM + wc * 32 + 8 * fq;
#pragma unroll
        for (int ai = 0; ai < 2; ++ai)
#pragma unroll
            for (int m = 0; m < 4; ++m) {
                const int row = row0 + ai * HALF + m * 16;
                bf16_t* rowp = O + (size_t)row * ldc + col0;
                float ss = 0.f;
#pragma unroll
                for (int bj = 0; bj < 2; ++bj) {
                    const f32x4 v0 = acc[ai][bj][m][0], v1 = acc[ai][bj][m][1];
                    u32x4 w; w.x = pk2(v0[0], v0[1]); w.y = pk2(v0[2], v0[3]); w.z = pk2(v1[0], v1[1]); w.w = pk2(v1[2], v1[3]);
                    *(u32x4*)(rowp + bj * HALF) = w;
                    ss += v0[0] * v0[0] + v0[1] * v0[1] + v0[2] * v0[2] + v0[3] * v0[3] + v1[0] * v1[0] + v1[1] * v1[1] + v1[2] * v1[2] + v1[3] * v1[3];
                }
                if (rowss) { ss += __shfl_xor(ss, 16); ss += __shfl_xor(ss, 32); if (fq == 0) atomicAdd(rowss + row, ss); }
                __builtin_amdgcn_sched_barrier(0);
            }
        return false;
    }
};

struct EpiLora {
    const Params* P;
    __device__ __forceinline__ bool operator()(Acc& acc, const Unit& u, int wr, int wc, int fr_, int fq_) const {
        int fr = fr_, fq = fq_; asm volatile("" : "+v"(fr), "+v"(fq));
        const int sec = u.pn >> 1, cb = (u.pn & 1) * 256 + wc * 32 + 8 * fq, row0 = u.pm * BM + wr * 64 + fr;
        bf16_t* O = wsbw(*P, sec == 0 ? E_O : (sec == 1 ? ASIG_O : G_O));
        const float* bias = sec == 0 ? P->in[I_W0] : P->in[I_A0];
#pragma unroll
        for (int bj = 0; bj < 2; ++bj) {
            const int c = cb + bj * HALF;
            float bv[8];
            if (sec < 2) ld8f(bias + c, bv); else { for (int i = 0; i < 8; ++i) bv[i] = 0.f; }
#pragma unroll
            for (int ai = 0; ai < 2; ++ai)
#pragma unroll
                for (int m = 0; m < 4; ++m) {
                    int row = row0 + ai * HALF + m * 16; asm volatile("" : "+v"(row));
                    float v[8];
#pragma unroll
                    for (int i = 0; i < 8; ++i) v[i] = acc[ai][bj][m][i >> 2][i & 3] + bv[i];
                    if (sec == 0) { for (int i = 0; i < 8; ++i) v[i] = 0.6065306597f * sigm(v[i]); }
                    else if (sec == 1) { for (int i = 0; i < 8; ++i) v[i] = sigm(v[i]); }
                    *(u32x4*)(O + (size_t)row * 512 + c) = pack8(v);
                    __builtin_amdgcn_sched_barrier(0);
                }
        }
        return false;
    }
};

struct EpiLru {
    const Params* P;
    __device__ __forceinline__ bool operator()(Acc& acc, const Unit& u, int wr, int wc, int fr_, int fq_) const {
        int fr = fr_, fq = fq_; asm volatile("" : "+v"(fr), "+v"(fq));
        const int ch = u.pn * 128 + wc * 32 + 8 * fq, row0 = u.pm * BM + wr * 64 + fr;
        float gxb[8], gab[8], sp[8];
        ld8f(P->in[I_GXB] + ch, gxb); ld8f(P->in[I_GAB] + ch, gab); ld8f(P->in[I_LAM] + ch, sp);
#pragma unroll
        for (int i = 0; i < 8; ++i) sp[i] = -8.f * log1pf(__expf(-sp[i]));
        const bf16_t* XC = outb(*P, XC_O);
        bf16_t* LLA = outb(*P, LLA_O); bf16_t* LU = outb(*P, LU_O);
#pragma unroll
        for (int ai = 0; ai < 2; ++ai) {
            u32x4 xcr[4];
#pragma unroll
            for (int m = 0; m < 4; ++m) xcr[m] = *(const u32x4*)(XC + (size_t)(row0 + ai * HALF + m * 16) * 512 + ch);
#pragma unroll
            for (int m = 0; m < 4; ++m) {
                int row = row0 + ai * HALF + m * 16; asm volatile("" : "+v"(row));
                float xc[8], la[8], uu[8];
                unpack8(xcr[m], xc);
#pragma unroll
                for (int i = 0; i < 8; ++i) {
                    const float gx = sigm(acc[ai][0][m][i >> 2][i & 3] + gxb[i]);
                    const float ga = sigm(acc[ai][1][m][i >> 2][i & 3] + gab[i]);
                    la[i] = ga * sp[i];
                    uu[i] = __builtin_amdgcn_sqrtf(fmaxf(1.f - __expf(2.f * la[i]), 0.f)) * gx * xc[i];
                }
                *(u32x4*)(LLA + (size_t)row * 512 + ch) = pack8(la);
                *(u32x4*)(LU + (size_t)row * 512 + ch) = pack8(uu);
            }
            __builtin_amdgcn_sched_barrier(0);
        }
        return false;
    }
};

struct EpiMix {
    const Params* P;
    __device__ __forceinline__ bool operator()(Acc& acc, const Unit& u, int wr, int wc, int fr_, int fq_) const {
        int fr = fr_, fq = fq_; asm volatile("" : "+v"(fr), "+v"(fq));
        const int row0 = u.pm * BM + wr * 64 + fr, col0 = u.pn * BM + wc * 32 + 8 * fq;
        const bf16_t* proj = wsb(*P, PROJ_O);
        bf16_t* O = wsbw(*P, MIXIN_O);
        if (u.kind == 1) {
#pragma unroll
            for (int ai = 0; ai < 2; ++ai) {
                u32x4 gq[4][2];
#pragma unroll
                for (int m = 0; m < 4; ++m)
#pragma unroll
                    for (int bj = 0; bj < 2; ++bj) gq[m][bj] = *(const u32x4*)(proj + (size_t)(row0 + ai * HALF + m * 16) * INC + 3328 + col0 + bj * HALF);
#pragma unroll
                for (int m = 0; m < 4; ++m)
#pragma unroll
                    for (int bj = 0; bj < 2; ++bj) {
                        float gb[8], v[8];
                        unpack8(gq[m][bj], gb);
#pragma unroll
                        for (int i = 0; i < 8; ++i) v[i] = acc[ai][bj][m][i >> 2][i & 3] * sigm(gb[i]);
                        *(u32x4*)(O + (size_t)(row0 + ai * HALF + m * 16) * 1024 + col0 + bj * HALF) = pack8(v);
                    }
                __builtin_amdgcn_sched_barrier(0);
            }
            return false;
        }
#pragma unroll
        for (int am = 0; am < 4; ++am) {
            const int ai = am >> 1, m0 = (am & 1) * 2;
            u32x4 gbr[2][2], gar[2][2];
#pragma unroll
            for (int mm = 0; mm < 2; ++mm)
#pragma unroll
                for (int bj = 0; bj < 2; ++bj) {
                    const bf16_t* gp = proj + (size_t)(row0 + ai * HALF + (m0 + mm) * 16) * INC + 2304 + col0 + bj * HALF;
                    gbr[mm][bj] = *(const u32x4*)(gp + 1024);
                    if (u.kind == 0) gar[mm][bj] = *(const u32x4*)gp;
                }
#pragma unroll
            for (int mm = 0; mm < 2; ++mm) {
                const int m = m0 + mm, row = row0 + ai * HALF + m * 16;
#pragma unroll
                for (int bj = 0; bj < 2; ++bj) {
                    const int col = col0 + bj * HALF;
                    float gb[8];
                    unpack8(gbr[mm][bj], gb);
                    if (u.kind == 0) {
                        float ga[8];
                        unpack8(gar[mm][bj], ga);
#pragma unroll
                        for (int i = 0; i < 8; ++i) acc[ai][bj][m][i >> 2][i & 3] *= (1.f + __expf(-gb[i])) * rcp_(1.f + __expf(-ga[i]));
                    } else {
                        float v[8];
#pragma unroll
                        for (int i = 0; i < 8; ++i) v[i] = acc[ai][bj][m][i >> 2][i & 3] * sigm(gb[i]);
                        *(u32x4*)(O + (size_t)row * 1024 + col) = pack8(v);
                    }
                }
            }
            __builtin_amdgcn_sched_barrier(0);
        }
        return u.kind == 0;
    }
};

struct EpiUp {
    const Params* P;
    __device__ __forceinline__ bool operator()(Acc& acc, const Unit& u, int wr, int wc, int fr_, int fq_) const {
        int fr = fr_, fq = fq_; asm volatile("" : "+v"(fr), "+v"(fq));
        const int cg0 = u.pn * 128 + wc * 32 + 8 * fq;
        const float* cw = P->in[I_FCW]; const float* cbias = P->in[I_FCB];
        bf16_t* ACT = wsbw(*P, ACT_O);
        float* STASH = (float*)(P->ws + STASH_O);
#pragma unroll
        for (int n = 0; n < 2; ++n) {
            const int cg = cg0 + 4 * n;
            const f32x4 wg0 = *(const f32x4*)(cw + cg), wg1 = *(const f32x4*)(cw + DFF2 + cg), wg2 = *(const f32x4*)(cw + 2 * DFF2 + cg), bg = *(const f32x4*)(cbias + cg);
            const f32x4 wv0 = *(const f32x4*)(cw + DFF + cg), wv1 = *(const f32x4*)(cw + DFF2 + DFF + cg), wv2 = *(const f32x4*)(cw + 2 * DFF2 + DFF + cg), bv = *(const f32x4*)(cbias + DFF + cg);
            if (u.pm < 64) {
#pragma unroll
                for (int ai = 0; ai < 2; ++ai)
#pragma unroll
                    for (int m = 0; m < 4; ++m) {
                        const int rr = m * 16 + fr, row = u.pm * BM + ai * HALF + wr * 64 + rr;
                        const f32x4 g0 = acc[ai][0][m][n], v0 = acc[ai][1][m][n];
                        const f32x4 gp = acc[ai][0][m > 0 ? m - 1 : 0][n], vp = acc[ai][1][m > 0 ? m - 1 : 0][n];
                        float a[4], s1[8], s2[8];
#pragma unroll
                        for (int j = 0; j < 4; ++j) { s1[j] = fr == 15 ? gp[j] : g0[j]; s2[j] = fr >= 14 ? gp[j] : g0[j]; s1[4 + j] = fr == 15 ? vp[j] : v0[j]; s2[4 + j] = fr >= 14 ? vp[j] : v0[j]; }
                        __builtin_amdgcn_sched_barrier(0);
#pragma unroll
                        for (int j = 0; j < 8; ++j) { s1[j] = ror1(s1[j]); s2[j] = ror2(s2[j]); }
                        __builtin_amdgcn_sched_barrier(0);
#pragma unroll
                        for (int j = 0; j < 4; ++j) {
                            a[j] = gelu_t(fma_s(wg2[j], g0[j], fma_s(wg1[j], s1[j], fma_s(wg0[j], s2[j], bg[j]))));
                            a[j] *= fma_s(wv2[j], v0[j], fma_s(wv1[j], s1[4 + j], fma_s(wv0[j], s2[4 + j], bv[j])));
                        }
                        if (rr >= 2) {
                            u32x2 w; w.x = pk2(a[0], a[1]); w.y = pk2(a[2], a[3]);
                            *(u32x2*)(ACT + (size_t)row * DFF + cg) = w;
                        }
                        if (rr < 2 || rr >= 62) {
                            float* sp = STASH + ((size_t)(row >> 6) * 4 + (rr < 2 ? rr : rr - 60)) * DFF2;
                            *(f32x4*)(sp + cg) = g0; *(f32x4*)(sp + DFF + cg) = v0;
                        }
                        __builtin_amdgcn_sched_barrier(0);
                    }
            } else {
                float* SUP = (float*)(P->ws + SUP_O);
#pragma unroll
                for (int m = 0; m < 4; ++m) {
                    const int b = wr * 64 + m * 16 + fr;
                    *(f32x4*)(SUP + (size_t)b * DFF2 + cg) = acc[0][0][m][n]; *(f32x4*)(SUP + (size_t)b * DFF2 + DFF + cg) = acc[0][1][m][n];
                }
            }
        }
        return false;
    }
};

__device__ void phase0(const Params& P, LAS unsigned char* ldsb, int bid, int nb) {
    LAS float* tile = (LAS float*)ldsb;
    const int tid = TID(), wid = tid >> 6, lane = tid & 63;
    const int nt_in = 16 * 68, nt_a = 8 * 16, nt_b = 8 * 16, nt_o = 16 * 16, nt_up = 16 * 88, nt_dn = 44 * 16;
    const int total = (nb == 256) ? nt_in : nt_in + nt_a + nt_b + nt_o + nt_up + nt_dn;
    auto tile_info = [&](int j, const float*& src, bf16_t*& dst, int& K, int& N, int& k0, int& n0, int& drow0) {
        int jj = j, mode = 0;
        if (jj < nt_in) { src = P.in[I_WIN]; dst = wsbw(P, W_IN_T); K = 1024; N = 4352; }
        else if ((jj -= nt_in) < nt_a) { src = P.in[I_WOUT]; dst = wsbw(P, W_A_T); K = 512; N = 1024; }
        else if ((jj -= nt_a) < nt_b) { src = P.in[I_LWOUT]; dst = wsbw(P, W_B_T); K = 512; N = 1024; }
        else if ((jj -= nt_b) < nt_o) { src = P.in[I_WO]; dst = wsbw(P, W_O_T); K = 1024; N = 1024; }
        else if ((jj -= nt_o) < nt_up) { src = P.in[I_FUP]; dst = wsbw(P, W_UP_T); K = 1024; N = 5632; mode = 1; }
        else { jj -= nt_up; src = P.in[I_FDN]; dst = wsbw(P, W_DN_T); K = 2816; N = 1024; }
        const int ntn = N / 64; k0 = (jj / ntn) * 64; n0 = (jj % ntn) * 64;
        drow0 = n0;
        if (mode == 1) { if (n0 < DFF) drow0 = (n0 / 128) * 256 + (n0 % 128); else { const int q = n0 - DFF; drow0 = (q / 128) * 256 + 128 + (q % 128); } }
    };
    {
        f32x4 rv[2];
        const float* src; bf16_t* dst; int K, N, k0, n0, drow0;
        int j = bid;
        if (j < total) { tile_info(j, src, dst, K, N, k0, n0, drow0);
#pragma unroll
            for (int i = 0; i < 2; ++i) { const int idx = tid + 512 * i, kk = idx >> 4, n4 = (idx & 15) * 4; rv[i] = __builtin_nontemporal_load((const f32x4*)(src + (size_t)(k0 + kk) * N + n0 + n4)); } }
        while (j < total) {
#pragma unroll
            for (int i = 0; i < 2; ++i) { const int idx = tid + 512 * i, kk = idx >> 4, n4 = (idx & 15) * 4;
                tile[kk * 65 + n4] = rv[i].x; tile[kk * 65 + n4 + 1] = rv[i].y; tile[kk * 65 + n4 + 2] = rv[i].z; tile[kk * 65 + n4 + 3] = rv[i].w; }
            bf16_t* cdst = dst; const int cK = K, ck0 = k0, cdrow0 = drow0;
            j += nb;
            if (j < total) { tile_info(j, src, dst, K, N, k0, n0, drow0);
#pragma unroll
                for (int i = 0; i < 2; ++i) { const int idx = tid + 512 * i, kk = idx >> 4, n4 = (idx & 15) * 4; rv[i] = __builtin_nontemporal_load((const f32x4*)(src + (size_t)(k0 + kk) * N + n0 + n4)); } }
            asm volatile("s_waitcnt lgkmcnt(0)\n\ts_barrier" ::: "memory");
#pragma unroll
            for (int i = 0; i < 4; ++i) { const int idx = tid + 512 * i, nn = idx >> 5, kp = idx & 31;
                *(unsigned*)(cdst + (size_t)(cdrow0 + nn) * cK + ck0 + 2 * kp) = pk2(tile[(2 * kp) * 65 + nn], tile[(2 * kp + 1) * 65 + nn]); }
            asm volatile("s_waitcnt lgkmcnt(0)\n\ts_barrier" ::: "memory");
        }
    }
    const int gtid = bid * 512 + tid, gth = nb * 512;
    { bf16_t* W = wsbw(P, W_LORA_T);
      for (int idx = gtid; idx < 256 * 512; idx += gth) { const int k = idx >> 9, n = idx & 511;
          const float v = k < 64 ? P.in[I_WUP][k * 512 + n] : (k < 128 ? P.in[I_AUP][(k - 64) * 512 + n] : P.in[I_GUP][(k - 128) * 512 + n]);
          const int sec = k < 64 ? 0 : (k < 128 ? 1 : 2);
#pragma unroll
          for (int t = 0; t < 3; ++t) W[(size_t)(t * 512 + n) * 256 + k] = (t == sec) ? f2bf(v) : (bf16_t)0; } }
    { bf16_t* W = wsbw(P, W_LRUG_T);
      for (int idx = gtid; idx < 512 * 1024; idx += gth) { const int k = idx >> 10, n = idx & 1023; const int pn = n >> 8, wi = n & 255, ch = pn * 128 + (wi & 127), blk = ch >> 6, jc = ch & 63;
          float v = 0.f; if ((k >> 6) == blk) v = (wi >= 128 ? P.in[I_GAW] : P.in[I_GXW])[blk * 4096 + (k & 63) * 64 + jc];
          W[(size_t)n * 512 + k] = f2bf(v); } }
    { float* r1 = (float*)(P.ws + ROWSS1); float* r2 = (float*)(P.ws + ROWSS2);
      for (int idx = gtid; idx < MPAD; idx += gth) { r1[idx] = 0.f; r2[idx] = 0.f; } }
    bf16_t* XN = wsbw(P, XN_O);
    for (int rowA = bid * 8 + wid; rowA < MP; rowA += nb * 16) {
        const int rowB = rowA + nb * 8; const bool hasB = rowB < MP; const int rows[2] = {rowA, hasB ? rowB : rowA};
        f32x4 v[2][4]; float ss[2] = {0.f, 0.f};
#pragma unroll
        for (int q = 0; q < 2; ++q)
#pragma unroll
            for (int i = 0; i < 4; ++i) v[q][i] = __builtin_nontemporal_load((const f32x4*)(P.in[I_XP] + (size_t)rows[q] * 1024 + lane * 4 + 256 * i));
#pragma unroll
        for (int q = 0; q < 2; ++q)
#pragma unroll
            for (int i = 0; i < 4; ++i) ss[q] += v[q][i].x * v[q][i].x + v[q][i].y * v[q][i].y + v[q][i].z * v[q][i].z + v[q][i].w * v[q][i].w;
        ss[0] = wave_sum(ss[0]); ss[1] = wave_sum(ss[1]);
#pragma unroll
        for (int q = 0; q < 2; ++q) { const float sc = rsqrtf(ss[q] * (1.f / 1024.f) + 1e-6f);
            if (q == 0 || hasB) {
#pragma unroll
                for (int i = 0; i < 4; ++i) { const f32x4 g = *(const f32x4*)(P.in[I_NPM] + lane * 4 + 256 * i); const f32x4 t = v[q][i] * sc * g;
                    u32x2 w; w.x = pk2(t.x, t.y); w.y = pk2(t.z, t.w); *(u32x2*)(XN + (size_t)rows[q] * 1024 + lane * 4 + 256 * i) = w; } } }
    }
    for (int row = MP + bid * 8 + wid; row < MPAD; row += nb * 8) {
        bf16_t* o = XN + (size_t)row * 1024;
        if (row >= MT) { for (int i = 0; i < 4; ++i) *(u32x2*)(o + lane * 4 + 256 * i) = (u32x2){0u, 0u}; continue; }
        const float* x = row < MP ? P.in[I_XP] + (size_t)row * 1024 : P.in[I_XS] + (size_t)(row - MP) * 1024;
        f32x4 v[4]; float ss = 0.f;
#pragma unroll
        for (int i = 0; i < 4; ++i) { v[i] = *(const f32x4*)(x + lane * 4 + 256 * i); ss += v[i].x * v[i].x + v[i].y * v[i].y + v[i].z * v[i].z + v[i].w * v[i].w; }
        ss = wave_sum(ss);
        const float sc = rsqrtf(ss * (1.f / 1024.f) + 1e-6f);
#pragma unroll
        for (int i = 0; i < 4; ++i) { const f32x4 g = *(const f32x4*)(P.in[I_NPM] + lane * 4 + 256 * i);
            u32x2 w; w.x = pk2(v[i].x * sc * g.x, v[i].y * sc * g.y); w.y = pk2(v[i].z * sc * g.z, v[i].w * sc * g.w); *(u32x2*)(o + lane * 4 + 256 * i) = w; }
    }
}

__device__ void phase_b0(const Params& P, int bid, int nb) {
    const int tid = TID(), wid = tid >> 6, lane = tid & 63;
    const bf16_t* proj = wsb(P, PROJ_O);
    bf16_t* LA = outb(P, LA_O); bf16_t* XC = outb(P, XC_O); bf16_t* KK = wsbw(P, KK_O);
    for (int row = bid * 8 + wid; row < MPAD; row += nb * 8) {
        if (row >= MT) {
            const u32x4 z = (u32x4){0u, 0u, 0u, 0u};
            if (lane < 32) *(u32x4*)(LA + (size_t)row * 256 + 8 * lane) = z;
            *(u32x4*)(XC + (size_t)row * 512 + 8 * lane) = z; *(u32x4*)(KK + (size_t)row * 512 + 8 * lane) = z;
            continue;
        }
        const bool sample = row >= MP; const int b = sample ? row - MP : row >> 11, t = sample ? 0 : (row & 2047);
        float m[8];
        { shifted8(P, row, 512 + 8 * lane, m);
          float kk[8], kkw[8]; ld8f(P.in[I_KK] + 8 * lane, kkw); float ss = 0.f;
#pragma unroll
          for (int i = 0; i < 8; ++i) { kk[i] = m[i] * kkw[i]; ss += kk[i] * kk[i]; }
          ss += __shfl_xor(ss, 1); ss += __shfl_xor(ss, 2); ss += __shfl_xor(ss, 4);
          const float inv = 1.f / fmaxf(sqrtf(ss), 1e-12f);
#pragma unroll
          for (int i = 0; i < 8; ++i) kk[i] *= inv;
          *(u32x4*)(KK + (size_t)row * 512 + 8 * lane) = pack8(kk); }
        if (lane < 32) {
            shifted8(P, row, 1536 + 8 * lane, m);
            if (lane < 8) { for (int i = 0; i < 8; ++i) m[i] = tanh_(m[i]); }
            else if (lane >= 16) { for (int i = 0; i < 8; ++i) m[i] = sigm(m[i]); }
            *(u32x4*)(LA + (size_t)row * 256 + 8 * lane) = pack8(m);
        }
        { const int c0 = 8 * lane; float x0[8], x1[8], x2[8], x3[8];
          ld8bf(proj + (size_t)row * INC + RP + c0, x3);
          if (sample) { const float* sb = P.in[I_SLCONV] + (size_t)b * 3 * 512 + c0; ld8f(sb, x0); ld8f(sb + 512, x1); ld8f(sb + 1024, x2); }
          else {
              if (t >= 1) ld8bf(proj + (size_t)(row - 1) * INC + RP + c0, x2); else { for (int i = 0; i < 8; ++i) x2[i] = 0.f; }
              if (t >= 2) ld8bf(proj + (size_t)(row - 2) * INC + RP + c0, x1); else { for (int i = 0; i < 8; ++i) x1[i] = 0.f; }
              if (t >= 3) ld8bf(proj + (size_t)(row - 3) * INC + RP + c0, x0); else { for (int i = 0; i < 8; ++i) x0[i] = 0.f; }
          }
          float w0[8], w1[8], w2[8], w3[8], cb[8], xc[8];
          ld8f(P.in[I_LCW] + c0, w0); ld8f(P.in[I_LCW] + 512 + c0, w1); ld8f(P.in[I_LCW] + 1024 + c0, w2); ld8f(P.in[I_LCW] + 1536 + c0, w3); ld8f(P.in[I_LCB] + c0, cb);
#pragma unroll
          for (int i = 0; i < 8; ++i) xc[i] = cb[i] + w0[i] * x0[i] + w1[i] * x1[i] + w2[i] * x2[i] + w3[i] * x3[i];
          *(u32x4*)(XC + (size_t)row * 512 + c0) = pack8(xc);
          if (sample) { float* o = P.out + O_SLCONV + (size_t)b * 3 * 512 + c0; st8f(o, x1); st8f(o + 512, x2); st8f(o + 1024, x3); }
          else if (t == 2047) { float* o = P.out + O_PLCONV + (size_t)b * 3 * 512 + c0; st8f(o, x1); st8f(o + 512, x2); st8f(o + 1024, x3); }
        }
        if (sample || t == 2047) {
            float* o = P.out + (sample ? O_SSHIFT : O_PSHIFT) + (size_t)b * RP;
            for (int ci = lane; ci < 224; ci += 64) { float p[8]; ld8bf(proj + (size_t)row * INC + 8 * ci, p); st8f(o + 8 * ci, p); }
        }
    }
}

__device__ __forceinline__ void sample_wkv(const Params& P, int w0, int nw) {
    const int lane = TID() & 63, rowq = lane >> 4, kq = lane & 15;
    const bf16_t* proj = wsb(P, PROJ_O);
    const bf16_t* E = wsb(P, E_O); const bf16_t* AS = wsb(P, ASIG_O); const bf16_t* KK = wsb(P, KK_O);
    bf16_t* Y = wsbw(P, Y_O);
    for (int it = w0; it < 128 * 8; it += nw) {
        const int b = it >> 3, h = it & 7, row = MP + b, hc = h * 64 + 4 * kq, vc = 1024 + h * 64 + lane;
        const bf16_t* pr = proj + (size_t)row * INC; const float* sh = P.in[I_SSHIFT] + (size_t)b * RP; const float* mu = P.in[I_MU];
        const float* S0 = P.in[I_SWKV] + (size_t)(b * 8 + h) * 4096;
        float* S1 = P.out + O_SWKV + (size_t)(b * 8 + h) * 4096;
        f32x4 st[8];
#pragma unroll
        for (int i = 0; i < 8; ++i) st[i] = *(const f32x4*)(S0 + (4 * i + rowq) * 64 + 4 * kq);
        const u32x2 pr_r = *(const u32x2*)(pr + hc), pr_k = *(const u32x2*)(pr + 512 + hc);
        const f32x4 sh_r = *(const f32x4*)(sh + hc), sh_k = *(const f32x4*)(sh + 512 + hc), mu_r = *(const f32x4*)(mu + hc), mu_k = *(const f32x4*)(mu + 512 + hc);
        const f32x4 ka = *(const f32x4*)(P.in[I_KA] + hc);
        const u32x2 a4 = *(const u32x2*)(AS + (size_t)row * 512 + hc), kk4 = *(const u32x2*)(KK + (size_t)row * 512 + hc), e4 = *(const u32x2*)(E + (size_t)row * 512 + hc);
        const float pvv = bf1(pr[vc]), shv = sh[vc], muv = mu[vc];
        const float mv = pvv + muv * (shv - pvv);
        const float pr_[4] = {bflo(pr_r.x), bfhi(pr_r.x), bflo(pr_r.y), bfhi(pr_r.y)}, pk_[4] = {bflo(pr_k.x), bfhi(pr_k.x), bflo(pr_k.y), bfhi(pr_k.y)};
        const float a_[4] = {bflo(a4.x), bfhi(a4.x), bflo(a4.y), bfhi(a4.y)}, kk_[4] = {bflo(kk4.x), bfhi(kk4.x), bflo(kk4.y), bfhi(kk4.y)}, e_[4] = {bflo(e4.x), bfhi(e4.x), bflo(e4.y), bfhi(e4.y)};
        float d[4], kp[4], na[4], nbv[4], r[4];
#pragma unroll
        for (int i = 0; i < 4; ++i) {
            r[i] = pr_[i] + mu_r[i] * (sh_r[i] - pr_[i]);
            const float mk = pk_[i] + mu_k[i] * (sh_k[i] - pk_[i]);
            d[i] = __expf(-e_[i]); kp[i] = mk * (1.f + (a_[i] - 1.f) * ka[i]); na[i] = -kk_[i]; nbv[i] = kk_[i] * a_[i];
        }
        { const f32x4 rk4 = *(const f32x4*)(P.in[I_RK] + hc);
          float bo = r[0] * kp[0] * rk4[0] + r[1] * kp[1] * rk4[1] + r[2] * kp[2] * rk4[2] + r[3] * kp[3] * rk4[3];
          bo = row16_sum(bo);
          if (lane == 0) ((float*)(P.ws + BON_O))[(size_t)row * 8 + h] = bo; }
#pragma unroll
        for (int i = 0; i < 16; ++i) {
            const int v = 4 * i + rowq;
            if (i == 8) {
#pragma unroll
                for (int i2 = 0; i2 < 8; ++i2) st[i2] = *(const f32x4*)(S0 + (4 * (8 + i2) + rowq) * 64 + 4 * kq);
            }
            f32x4 s = st[i & 7];
            const float vv = __shfl(mv, v);
            float sa = s.x * na[0] + s.y * na[1] + s.z * na[2] + s.w * na[3];
            sa = row16_sum(sa);
            s.x = s.x * d[0] + sa * nbv[0] + vv * kp[0]; s.y = s.y * d[1] + sa * nbv[1] + vv * kp[1];
            s.z = s.z * d[2] + sa * nbv[2] + vv * kp[2]; s.w = s.w * d[3] + sa * nbv[3] + vv * kp[3];
            float y = s.x * r[0] + s.y * r[1] + s.z * r[2] + s.w * r[3];
            y = row16_sum(y);
            *(f32x4*)(S1 + v * 64 + 4 * kq) = s;
            if (kq == 0) Y[(size_t)row * 512 + h * 64 + v] = f2bf(y);
        }
    }
}

typedef float f32x2 __attribute__((ext_vector_type(2)));
__device__ __forceinline__ void lru_pass1(const Params& P, int t0, int nt) {
    const bf16_t* LLA = outb(P, LLA_O); const bf16_t* LU = outb(P, LU_O);
    f32x2* CP = (f32x2*)(P.ws + CARRY_P); f32x2* CH = (f32x2*)(P.ws + CARRY_H);
    for (int idx = t0; idx < 8 * 64 * 256; idx += nt) {
        const int c2 = idx & 255, chunk = (idx >> 8) & 63, b = idx >> 14;
        const size_t base = ((size_t)b * 2048 + chunk * 32) * 512 + 2 * c2;
        float h0 = 0.f, h1 = 0.f, s0 = 0.f, s1 = 0.f;
#pragma unroll 1
        for (int hb = 0; hb < 2; ++hb) {
            unsigned la[16], uu[16];
#pragma unroll
            for (int t = 0; t < 16; ++t) { la[t] = __builtin_nontemporal_load((const unsigned*)(LLA + base + (size_t)(hb * 16 + t) * 512)); uu[t] = __builtin_nontemporal_load((const unsigned*)(LU + base + (size_t)(hb * 16 + t) * 512)); }
#pragma unroll
            for (int t = 0; t < 16; ++t) { const float a0 = bflo(la[t]), a1 = bfhi(la[t]); h0 = __expf(a0) * h0 + bflo(uu[t]); h1 = __expf(a1) * h1 + bfhi(uu[t]); s0 += a0; s1 += a1; }
        }
        CP[idx] = (f32x2){s0, s1}; CH[idx] = (f32x2){h0, h1};
    }
}
__device__ __forceinline__ void sample_lru(const Params& P, int t0, int nt) {
    const bf16_t* LLA = outb(P, LLA_O); bf16_t* LU = outb(P, LU_O);
    for (int idx = t0; idx < 256 * 512; idx += nt) {
        const int c = idx & 511, b = idx >> 9; const size_t o = (size_t)(MP + b) * 512 + c;
        if (b < 128) { const float h = __expf(bf1(LLA[o])) * P.in[I_SLH][b * 512 + c] + bf1(LU[o]); P.out[O_SLH + b * 512 + c] = h; LU[o] = f2bf(h); }
        else LU[o] = 0;
    }
}
__device__ void lru_pass2(const Params& P, int bid, int nb) {
    const bf16_t* LLA = outb(P, LLA_O); bf16_t* LU = outb(P, LU_O);
    const f32x2* CP = (const f32x2*)(P.ws + CARRY_P); const f32x2* CH = (const f32x2*)(P.ws + CARRY_H);
    for (int idx = bid * 512 + TID(); idx < 8 * 64 * 256; idx += nb * 512) {
        const int c2 = idx & 255, chunk = (idx >> 8) & 63, b = idx >> 14;
        const size_t base = ((size_t)b * 2048 + chunk * 32) * 512 + 2 * c2;
        unsigned la[32], uu[32];
#pragma unroll
        for (int t = 0; t < 32; ++t) { la[t] = __builtin_nontemporal_load((const unsigned*)(LLA + base + (size_t)t * 512)); uu[t] = __builtin_nontemporal_load((const unsigned*)(LU + base + (size_t)t * 512)); }
        float h0 = 0.f, h1 = 0.f;
        for (int j0 = 0; j0 < chunk; j0 += 16) {
            f32x2 cp[16], ch[16];
#pragma unroll
            for (int i = 0; i < 16; ++i) { const int j = (j0 + i < chunk) ? j0 + i : chunk - 1; const int k = ((b * 64 + j) << 8) + c2; cp[i] = CP[k]; ch[i] = CH[k]; }
#pragma unroll
            for (int i = 0; i < 16; ++i) if (j0 + i < chunk) { h0 = __expf(cp[i].x) * h0 + ch[i].x; h1 = __expf(cp[i].y) * h1 + ch[i].y; }
        }
#pragma unroll
        for (int t = 0; t < 32; ++t) { h0 = __expf(bflo(la[t])) * h0 + bflo(uu[t]); h1 = __expf(bfhi(la[t])) * h1 + bfhi(uu[t]); *(unsigned*)(LU + base + (size_t)t * 512) = pk2(h0, h1); }
        if (chunk == 63) *(f32x2*)(P.out + O_PLH + b * 512 + 2 * c2) = (f32x2){h0, h1};
    }
}

constexpr int WT_A = 64 * 16, WT_B = 64 * 16, WT_O = 128 * 16, WT_UP = 128 * 88, WT_DN = 352 * 16, WT_TOTAL = WT_A + WT_B + WT_O + WT_UP + WT_DN;
__device__ __forceinline__ void wt_task(const Params& P, int task, int lane, const float*& src, int& N, bf16_t*& dstp) {
    int j = task, K, mode = 0; bf16_t* dst;
    if (j < WT_A) { src = P.in[I_WOUT]; dst = wsbw(P, W_A_T); K = 512; N = 1024; }
    else if ((j -= WT_A) < WT_B) { src = P.in[I_LWOUT]; dst = wsbw(P, W_B_T); K = 512; N = 1024; }
    else if ((j -= WT_B) < WT_O) { src = P.in[I_WO]; dst = wsbw(P, W_O_T); K = 1024; N = 1024; }
    else if ((j -= WT_O) < WT_UP) { src = P.in[I_FUP]; dst = wsbw(P, W_UP_T); K = 1024; N = 5632; mode = 1; }
    else { j -= WT_UP; src = P.in[I_FDN]; dst = wsbw(P, W_DN_T); K = 2816; N = 1024; }
    const int ntn = N / 64, k0 = (j / ntn) * 8, n = (j % ntn) * 64 + lane;
    int drow = n;
    if (mode == 1) { if (n < DFF) drow = (n / 128) * 256 + (n % 128); else { const int q = n - DFF; drow = (q / 128) * 256 + 128 + (q % 128); } }
    src += (size_t)k0 * N + n; dstp = dst + (size_t)drow * K + k0;
}

constexpr int CHS = 32, REC = 388, NCH = 2048 / CHS;
#define SC_BAR() asm volatile("s_waitcnt lgkmcnt(0)\n\ts_barrier" ::: "memory")
template <bool EXTRAS>
__device__ void wkv_scan(const Params& P, int it, LAS float* lds, int bid, int nb) {
    const int tid = TID(), wid = __builtin_amdgcn_readfirstlane(tid >> 6), lane = tid & 63;
    const int xcd = it & 7, jj = it >> 3, s = jj & 3, bh = xcd + 8 * (jj >> 2), b = bh >> 3, h = bh & 7;
    LAS float* buf0 = lds; LAS float* buf1 = lds + CHS * REC; LAS float* yb = lds + 2 * CHS * REC;
    const size_t rowbase = (size_t)b * 2048;
    if (wid >= 4) {
        const int p = tid - 256, st = p >> 3, c8 = (p & 7) * 8, hc = h * 64 + c8;
        const bf16_t* proj = wsb(P, PROJ_O); const bf16_t* E = wsb(P, E_O); const bf16_t* AS = wsb(P, ASIG_O); const bf16_t* KK = wsb(P, KK_O);
        bf16_t* Y_ = wsbw(P, Y_O);
        float mur[8], muk[8], muv[8], ka[8];
        ld8f(P.in[I_MU] + hc, mur); ld8f(P.in[I_MU] + 512 + hc, muk); ld8f(P.in[I_MU] + 1024 + hc, muv); ld8f(P.in[I_KA] + hc, ka);
        struct Raw { u32x4 r, k, v, rp, kp, vp, e, a, kk; };
        Raw X, Y;
#define SC_LOAD(L, chunk) do { const int t_ = (chunk) * CHS + st; const size_t row_ = rowbase + t_; const bf16_t* pr_ = proj + row_ * INC + hc; \
        L.r = *(const u32x4*)pr_; L.k = *(const u32x4*)(pr_ + 512); L.v = *(const u32x4*)(pr_ + 1024); \
        if (t_ > 0) { L.rp = *(const u32x4*)(pr_ - INC); L.kp = *(const u32x4*)(pr_ - INC + 512); L.vp = *(const u32x4*)(pr_ - INC + 1024); } \
        else { L.rp = (u32x4){0u, 0u, 0u, 0u}; L.kp = L.rp; L.vp = L.rp; } \
        L.e = *(const u32x4*)(E + row_ * 512 + hc); L.a = *(const u32x4*)(AS + row_ * 512 + hc); L.kk = *(const u32x4*)(KK + row_ * 512 + hc); } while (0)
#define SC_WRITE(L, buf, chunk) do { LAS float* rec_ = (buf) + st * REC + c8; float r_[8], rp_[8], k_[8], kpv_[8], v_[8], vp_[8], e_[8], a_[8], kk_[8]; \
        unpack8(L.r, r_); unpack8(L.rp, rp_); unpack8(L.k, k_); unpack8(L.kp, kpv_); unpack8(L.v, v_); unpack8(L.vp, vp_); unpack8(L.e, e_); unpack8(L.a, a_); unpack8(L.kk, kk_); \
        float od_[8], ok_[8], ona_[8], onb_[8], or_[8], ov_[8]; \
        _Pragma("unroll") for (int i = 0; i < 8; ++i) { or_[i] = r_[i] + mur[i] * (rp_[i] - r_[i]); const float mk_ = k_[i] + muk[i] * (kpv_[i] - k_[i]); ov_[i] = v_[i] + muv[i] * (vp_[i] - v_[i]); \
            od_[i] = __expf(-e_[i]); ok_[i] = mk_ * (1.f + (a_[i] - 1.f) * ka[i]); ona_[i] = -kk_[i]; onb_[i] = kk_[i] * a_[i]; } \
        LAS float* nd_ = (buf) + st * REC + c8; \
        *(LAS f32x4*)(nd_) = (f32x4){ona_[0], od_[0] * or_[0], ona_[1], od_[1] * or_[1]}; *(LAS f32x4*)(nd_ + 64) = (f32x4){ona_[2], od_[2] * or_[2], ona_[3], od_[3] * or_[3]}; \
        *(LAS f32x4*)(nd_ + 4) = (f32x4){ona_[4], od_[4] * or_[4], ona_[5], od_[5] * or_[5]}; *(LAS f32x4*)(nd_ + 68) = (f32x4){ona_[6], od_[6] * or_[6], ona_[7], od_[7] * or_[7]}; \
        *(LAS f32x4*)(rec_ + 128) = (f32x4){od_[0], od_[1], od_[2], od_[3]}; *(LAS f32x4*)(rec_ + 132) = (f32x4){od_[4], od_[5], od_[6], od_[7]}; \
        *(LAS f32x4*)(rec_ + 192) = (f32x4){ok_[0], ok_[1], ok_[2], ok_[3]}; *(LAS f32x4*)(rec_ + 196) = (f32x4){ok_[4], ok_[5], ok_[6], ok_[7]}; \
        *(LAS f32x4*)(rec_ + 256) = (f32x4){onb_[0], onb_[1], onb_[2], onb_[3]}; *(LAS f32x4*)(rec_ + 260) = (f32x4){onb_[4], onb_[5], onb_[6], onb_[7]}; \
        { float c1_ = 0.f, c2_ = 0.f, bo_ = 0.f; float rkc_[8]; ld8f(P.in[I_RK] + hc, rkc_);     \
          _Pragma("unroll") for (int i = 0; i < 8; ++i) { c1_ += onb_[i] * or_[i]; c2_ += ok_[i] * or_[i]; bo_ += ok_[i] * or_[i] * rkc_[i]; } \
          c1_ += __shfl_xor(c1_, 1); c2_ += __shfl_xor(c2_, 1); bo_ += __shfl_xor(bo_, 1); c1_ += __shfl_xor(c1_, 2); c2_ += __shfl_xor(c2_, 2); bo_ += __shfl_xor(bo_, 2); \
          c1_ += __shfl_xor(c1_, 4); c2_ += __shfl_xor(c2_, 4); bo_ += __shfl_xor(bo_, 4); \
          if (s == 0 && (p & 7) == 0) ((float*)(P.ws + BON_O))[(rowbase + (chunk) * CHS + st) * 8 + h] = bo_; \
          LAS float* rs_ = (buf) + st * REC + 320 + 8 * (p & 7); *(LAS f32x2*)(rs_) = (f32x2){c1_, c2_}; *(LAS f32x2*)(rs_ + 4) = (f32x2){c1_, c2_}; } \
        if ((c8 >> 4) == s) { LAS float* vr_ = (buf) + st * REC + 320 + 4 * (c8 & 15) + 2; _Pragma("unroll") for (int i = 0; i < 8; ++i) vr_[4 * i] = ov_[i]; } } while (0)
#define SC_FLUSH(chunk) do { const LAS float* yy_ = yb + ((chunk) & 1) * CHS * 16 + st * 16 + 2 * (p & 7); \
        *(unsigned*)(Y_ + (rowbase + (chunk) * CHS + st) * 512 + h * 64 + 16 * s + 2 * (p & 7)) = pk2(yy_[0], yy_[1]); } while (0)
        SC_LOAD(X, 0); SC_LOAD(Y, 1); SC_WRITE(X, buf0, 0); SC_LOAD(X, 2);
        SC_BAR();
        for (int c = 0; c < NCH; c += 2) {
            if (c + 1 < NCH) SC_WRITE(Y, buf1, c + 1);
            if (c + 3 < NCH) SC_LOAD(Y, c + 3);
            if (c > 0) SC_FLUSH(c - 1);
            float wtv[8]; bf16_t* wtd = nullptr;
            if (EXTRAS) {
                int pp = p; asm volatile("" : "+v"(pp));
                if (c == 46) lru_pass1(P, bid * 256 + pp, nb * 256);
                else if (c == 50) sample_lru(P, bid * 256 + pp, nb * 256);
                else if (c == 54) sample_wkv(P, bid * 4 + (pp >> 6), nb * 4);
                const int task = (c < 44) ? bid * 4 + (pp >> 6) + nb * 4 * (c >> 1) : WT_TOTAL;
                if (task < WT_TOTAL) { const float* src; int N;
                    wt_task(P, task, pp & 63, src, N, wtd);
#pragma unroll
                    for (int i = 0; i < 8; ++i) wtv[i] = __builtin_nontemporal_load(src + (size_t)i * N); }
            }
            SC_BAR();
            if (EXTRAS && wtd) { u32x4 w0; w0.x = pk2(wtv[0], wtv[1]); w0.y = pk2(wtv[2], wtv[3]); w0.z = pk2(wtv[4], wtv[5]); w0.w = pk2(wtv[6], wtv[7]); *(u32x4*)wtd = w0; }
            if (c + 2 < NCH) SC_WRITE(X, buf0, c + 2);
            if (c + 4 < NCH) SC_LOAD(X, c + 4);
            SC_FLUSH(c);
            SC_BAR();
        }
        SC_FLUSH(NCH - 1);
#undef SC_LOAD
#undef SC_WRITE
#undef SC_FLUSH
    } else {
        const int rowq = lane >> 4, kq = lane & 15, rloc = 4 * wid + rowq;
        f32x4 S = (f32x4){0.f, 0.f, 0.f, 0.f};
        struct Ops { f32x4 nd0, nd1, d, kp, nb, rs; };
#define SC_LD(X, st_) do { X.nd0 = *(const LAS f32x4*)(bk4 + (st_) * REC - 128); X.nd1 = *(const LAS f32x4*)(bk4 + (st_) * REC - 64); \
        X.d = *(const LAS f32x4*)(bk4 + (st_) * REC); X.kp = *(const LAS f32x4*)(bk4 + (st_) * REC + 64); X.nb = *(const LAS f32x4*)(bk4 + (st_) * REC + 128); \
        X.rs = *(const LAS f32x4*)(br + (st_) * REC); } while (0)
#define SC_STEP(X, j_) do { f32x2 p_ = (f32x2){S.x, S.x} * (f32x2){X.nd0.x, X.nd0.y}; p_ = (f32x2){S.y, S.y} * (f32x2){X.nd0.z, X.nd0.w} + p_; \
        p_ = (f32x2){S.z, S.z} * (f32x2){X.nd1.x, X.nd1.y} + p_; p_ = (f32x2){S.w, S.w} * (f32x2){X.nd1.z, X.nd1.w} + p_; \
        const f32x4 T_ = S * X.d + X.rs.z * X.kp; \
        float sa_ = p_.x, q_ = p_.y; \
        sa_ += dppf<0xB1>(sa_); q_ += dppf<0xB1>(q_); sa_ += dppf<0x4E>(sa_); q_ += dppf<0x4E>(q_); sa_ += dppf<0x141>(sa_); q_ += dppf<0x141>(q_); sa_ += dppf<0x140>(sa_); q_ += dppf<0x140>(q_); \
        S = T_ + sa_ * X.nb; \
        const float y_ = q_ + sa_ * X.rs.x + X.rs.z * X.rs.y; yacc = (kq == (j_)) ? y_ : yacc; } while (0)
        SC_BAR();
        for (int c = 0; c < NCH; ++c) {
            const LAS float* bufc = (c & 1) ? buf1 : buf0; LAS float* ybc = yb + (c & 1) * CHS * 16;
            const LAS float* bk4 = bufc + 128 + 4 * kq; const LAS float* br = bufc + 320 + 4 * rloc;
            Ops A, B;
            SC_LD(A, 0);
#pragma unroll
            for (int g = 0; g < 2; ++g) {
                float yacc = 0.f;
#pragma unroll
                for (int j = 0; j < 16; j += 2) {
                    SC_LD(B, g * 16 + j + 1);
                    SC_STEP(A, j);
                    __builtin_amdgcn_sched_barrier(0);
                    if (g * 16 + j + 2 < CHS) SC_LD(A, g * 16 + j + 2);
                    SC_STEP(B, j + 1);
                    __builtin_amdgcn_sched_barrier(0);
                }
                ybc[(g * 16 + kq) * 16 + rloc] = yacc;
            }
            SC_BAR();
        }
#undef SC_LD
#undef SC_STEP
        *(f32x4*)(P.out + O_PWKV + ((size_t)(b * 8 + h) * 64 + 16 * s + rloc) * 64 + 4 * kq) = S;
    }
}

__device__ void phase_za(const Params& P, int bid, int nb) {
    const int tid = TID(), wid = tid >> 6, lane = tid & 63, c0 = 8 * lane;
    const bf16_t* G = wsb(P, G_O); const bf16_t* Y = wsb(P, Y_O);
    bf16_t* ZA = outb(P, ZA_O);
    for (int row = bid * 8 + wid; row < MPAD; row += nb * 8) {
        if (row >= MT) { *(u32x4*)(ZA + (size_t)row * 512 + c0) = (u32x4){0u, 0u, 0u, 0u}; continue; }
        float v[8], y[8], g[8], lw[8], lb[8], za[8];
        shifted8(P, row, 1024 + c0, v);
        ld8bf_nt(Y + (size_t)row * 512 + c0, y); ld8bf_nt(G + (size_t)row * 512 + c0, g);
        ld8f(P.in[I_LNW] + c0, lw); ld8f(P.in[I_LNB] + c0, lb);
        const float sb = ((const float*)(P.ws + BON_O))[(size_t)row * 8 + (lane >> 3)];
        float sy = 0.f;
#pragma unroll
        for (int i = 0; i < 8; ++i) sy += y[i];
        sy += __shfl_xor(sy, 1); sy += __shfl_xor(sy, 2); sy += __shfl_xor(sy, 4);
        const float mean = sy * (1.f / 64.f);
        float sv = 0.f;
#pragma unroll
        for (int i = 0; i < 8; ++i) { const float dd = y[i] - mean; sv += dd * dd; }
        sv += __shfl_xor(sv, 1); sv += __shfl_xor(sv, 2); sv += __shfl_xor(sv, 4);
        const float rs = rsqrtf(sv * (1.f / 64.f) + 64e-5f);
#pragma unroll
        for (int i = 0; i < 8; ++i) za[i] = ((y[i] - mean) * rs * lw[i] + lb[i] + sb * v[i]) * g[i];
        *(u32x4*)(ZA + (size_t)row * 512 + c0) = pack8(za);
    }
}

__device__ void phase_e(const Params& P, int bid, int nb) {
    const int tid = TID(), wid = tid >> 6, lane = tid & 63;
    const bf16_t* MIX = wsb(P, MIX_O); bf16_t* HN = wsbw(P, HN_O); const float* rss = (const float*)(P.ws + ROWSS1);
    for (int rowA = bid * 8 + wid; rowA < MP; rowA += nb * 16) {
        const int rowB = rowA + nb * 8; const bool hasB = rowB < MP; const int rB = hasB ? rowB : rowA;
        const int rows[2] = {rowA, rB};
        f32x4 xv[2][4]; u32x2 mb[2][4]; float rs[2];
#pragma unroll
        for (int q = 0; q < 2; ++q) { rs[q] = rss[rows[q]];
#pragma unroll
            for (int i = 0; i < 4; ++i) { const int c = lane * 4 + 256 * i; xv[q][i] = __builtin_nontemporal_load((const f32x4*)(P.in[I_XP] + (size_t)rows[q] * 1024 + c)); mb[q][i] = __builtin_nontemporal_load((const u32x2*)(MIX + (size_t)rows[q] * 1024 + c)); } }
        f32x4 g1[4], g2[4];
#pragma unroll
        for (int i = 0; i < 4; ++i) { g1[i] = *(const f32x4*)(P.in[I_NPOM] + lane * 4 + 256 * i); g2[i] = *(const f32x4*)(P.in[I_NPF] + lane * 4 + 256 * i); }
        float ss[2];
#pragma unroll
        for (int q = 0; q < 2; ++q) { const float sc = rsqrtf(rs[q] * (1.f / 1024.f) + 1e-6f); ss[q] = 0.f;
#pragma unroll
            for (int i = 0; i < 4; ++i) { const f32x4 m = (f32x4){bflo(mb[q][i].x), bfhi(mb[q][i].x), bflo(mb[q][i].y), bfhi(mb[q][i].y)};
                xv[q][i] = xv[q][i] + m * sc * g1[i];
                ss[q] += xv[q][i].x * xv[q][i].x + xv[q][i].y * xv[q][i].y + xv[q][i].z * xv[q][i].z + xv[q][i].w * xv[q][i].w; } }
        ss[0] = wave_sum(ss[0]); ss[1] = wave_sum(ss[1]);
#pragma unroll
        for (int q = 0; q < 2; ++q) { const float s2 = rsqrtf(ss[q] * (1.f / 1024.f) + 1e-6f);
            if (q == 0 || hasB) {
#pragma unroll
                for (int i = 0; i < 4; ++i) { const f32x4 t = xv[q][i] * s2 * g2[i]; u32x2 w; w.x = pk2(t.x, t.y); w.y = pk2(t.z, t.w); *(u32x2*)(HN + (size_t)rows[q] * 1024 + lane * 4 + 256 * i) = w; } } }
    }
    for (int row = MP + bid * 8 + wid; row < MPAD; row += nb * 8) {
        bf16_t* o = HN + (size_t)row * 1024;
        if (row >= MT) { for (int i = 0; i < 4; ++i) *(u32x2*)(o + lane * 4 + 256 * i) = (u32x2){0u, 0u}; continue; }
        const float* x = row < MP ? P.in[I_XP] + (size_t)row * 1024 : P.in[I_XS] + (size_t)(row - MP) * 1024;
        float* x1o = P.out + (size_t)row * 1024;
        f32x4 mx[4]; float sc;
        if (row < MP) {
#pragma unroll
            for (int i = 0; i < 4; ++i) { const u32x2 mb = *(const u32x2*)(MIX + (size_t)row * 1024 + lane * 4 + 256 * i); mx[i] = (f32x4){bflo(mb.x), bfhi(mb.x), bflo(mb.y), bfhi(mb.y)}; }
            sc = rsqrtf(rss[row] * (1.f / 1024.f) + 1e-6f);
        } else {
            const float* ms = (const float*)(P.ws + MIXS_O) + (size_t)(row - MP) * 1024; float s0 = 0.f;
#pragma unroll
            for (int i = 0; i < 4; ++i) { mx[i] = *(const f32x4*)(ms + lane * 4 + 256 * i); s0 += mx[i].x * mx[i].x + mx[i].y * mx[i].y + mx[i].z * mx[i].z + mx[i].w * mx[i].w; }
            sc = rsqrtf(wave_sum(s0) * (1.f / 1024.f) + 1e-6f);
        }
        f32x4 v[4]; float ss = 0.f;
#pragma unroll
        for (int i = 0; i < 4; ++i) {
            const int c = lane * 4 + 256 * i;
            const f32x4 xv = *(const f32x4*)(x + c), g = *(const f32x4*)(P.in[I_NPOM] + c);
            v[i] = xv + mx[i] * sc * g;
            *(f32x4*)(x1o + c) = v[i];
            ss += v[i].x * v[i].x + v[i].y * v[i].y + v[i].z * v[i].z + v[i].w * v[i].w;
        }
        ss = wave_sum(ss);
        const float s2 = rsqrtf(ss * (1.f / 1024.f) + 1e-6f);
#pragma unroll
        for (int i = 0; i < 4; ++i) { const int c = lane * 4 + 256 * i; const f32x4 g = *(const f32x4*)(P.in[I_NPF] + c);
            u32x2 w; w.x = pk2(v[i].x * s2 * g.x, v[i].y * s2 * g.y); w.y = pk2(v[i].z * s2 * g.z, v[i].w * s2 * g.w); *(u32x2*)(o + c) = w; }
    }
}

__device__ void phase_f2(const Params& P, int bid, int nb) {
    const float* STASH = (const float*)(P.ws + STASH_O);
    bf16_t* ACT = wsbw(P, ACT_O);
    const float* cw = P.in[I_FCW]; const float* cbias = P.in[I_FCB];
    for (int idx = bid * 512 + TID(); idx < 256 * 2 * 704; idx += nb * 512) {
        const int c = (idx % 704) * 4, q = idx / 704, rr = q & 1, g = q >> 1, row = g * 64 + rr;
        const bool first = (g & 31) == 0;
        const float* sc = STASH + (size_t)g * 4 * DFF2; const float* spv = sc - 4 * DFF2;
        f32x4 a;
#pragma unroll
        for (int half = 0; half < 2; ++half) {
            const int cc = c + half * DFF;
            const f32x4 z = (f32x4){0.f, 0.f, 0.f, 0.f};
            f32x4 x0, x1, x2;
            if (rr == 0) { x0 = *(const f32x4*)(sc + cc); x1 = first ? z : *(const f32x4*)(spv + 3 * DFF2 + cc); x2 = first ? z : *(const f32x4*)(spv + 2 * DFF2 + cc); }
            else { x0 = *(const f32x4*)(sc + DFF2 + cc); x1 = *(const f32x4*)(sc + cc); x2 = first ? z : *(const f32x4*)(spv + 3 * DFF2 + cc); }
            const f32x4 w0 = *(const f32x4*)(cw + cc), w1 = *(const f32x4*)(cw + DFF2 + cc), w2 = *(const f32x4*)(cw + 2 * DFF2 + cc), bb = *(const f32x4*)(cbias + cc);
            const f32x4 uu = bb + w0 * x2 + w1 * x1 + w2 * x0;
            if (half == 0) { a.x = gelu_t(uu.x); a.y = gelu_t(uu.y); a.z = gelu_t(uu.z); a.w = gelu_t(uu.w); }
            else a = a * uu;
        }
        u32x2 w; w.x = pk2(a.x, a.y); w.y = pk2(a.z, a.w);
        *(u32x2*)(ACT + (size_t)row * DFF + c) = w;
    }
    { const float* SUP = (const float*)(P.ws + SUP_O);
      for (int idx = bid * 512 + TID(); idx < 256 * 704; idx += nb * 512) {
        const int c = (idx % 704) * 4, b = idx / 704;
        if (b >= 128) { *(u32x2*)(ACT + (size_t)(MP + b) * DFF + c) = (u32x2){0u, 0u}; continue; }
        const float* st = P.in[I_SFCONV] + (size_t)b * 2 * DFF2; float* so = P.out + O_SFCONV + (size_t)b * 2 * DFF2;
        f32x4 a;
#pragma unroll
        for (int half = 0; half < 2; ++half) {
            const int cc = c + half * DFF;
            const f32x4 x0 = *(const f32x4*)(SUP + (size_t)b * DFF2 + cc), x1 = *(const f32x4*)(st + DFF2 + cc), x2 = *(const f32x4*)(st + cc);
            const f32x4 w0 = *(const f32x4*)(cw + cc), w1 = *(const f32x4*)(cw + DFF2 + cc), w2 = *(const f32x4*)(cw + 2 * DFF2 + cc), bb = *(const f32x4*)(cbias + cc);
            const f32x4 uu = bb + w0 * x2 + w1 * x1 + w2 * x0;
            if (half == 0) { a.x = gelu_t(uu.x); a.y = gelu_t(uu.y); a.z = gelu_t(uu.z); a.w = gelu_t(uu.w); }
            else a = a * uu;
            *(f32x4*)(so + cc) = x1; *(f32x4*)(so + DFF2 + cc) = x0;
        }
        u32x2 w; w.x = pk2(a.x, a.y); w.y = pk2(a.z, a.w);
        *(u32x2*)(ACT + (size_t)(MP + b) * DFF + c) = w;
      } }
    for (int idx = bid * 512 + TID(); idx < 8 * 2 * 1408; idx += nb * 512) {
        const int c = (idx % 1408) * 4, q = idx / 1408, j = q & 1, b = q >> 1;
        *(f32x4*)(P.out + O_PFCONV + ((size_t)b * 2 + j) * DFF2 + c) = *(const f32x4*)(STASH + ((size_t)(b * 32 + 31) * 4 + 2 + j) * DFF2 + c);
    }
}

__device__ void phase_h(const Params& P, int bid, int nb) {
    const int tid = TID(), wid = tid >> 6, lane = tid & 63;
    const bf16_t* F = wsb(P, F_O); const float* rss = (const float*)(P.ws + ROWSS2);
    const bf16_t* MIX = wsb(P, MIX_O); const float* rss1 = (const float*)(P.ws + ROWSS1);
    for (int rowA = bid * 8 + wid; rowA < MP; rowA += nb * 16) {
        const int rowB = rowA + nb * 8; const bool hasB = rowB < MP; const int rows[2] = {rowA, hasB ? rowB : rowA};
        f32x4 xv[2][4]; u32x2 fb[2][4], mb[2][4]; float rs[2], rs1[2];
#pragma unroll
        for (int q = 0; q < 2; ++q) { rs[q] = rss[rows[q]]; rs1[q] = rss1[rows[q]];
#pragma unroll
            for (int i = 0; i < 4; ++i) { const int c = lane * 4 + 256 * i; xv[q][i] = __builtin_nontemporal_load((const f32x4*)(P.in[I_XP] + (size_t)rows[q] * 1024 + c));
                fb[q][i] = __builtin_nontemporal_load((const u32x2*)(F + (size_t)rows[q] * 1024 + c)); mb[q][i] = __builtin_nontemporal_load((const u32x2*)(MIX + (size_t)rows[q] * 1024 + c)); } }
#pragma unroll
        for (int q = 0; q < 2; ++q) { const float sc = rsqrtf(rs[q] * (1.f / 1024.f) + 1e-6f), sc1 = rsqrtf(rs1[q] * (1.f / 1024.f) + 1e-6f);
            if (q == 0 || hasB) {
#pragma unroll
                for (int i = 0; i < 4; ++i) { const f32x4 g = *(const f32x4*)(P.in[I_NPOF] + lane * 4 + 256 * i), g1 = *(const f32x4*)(P.in[I_NPOM] + lane * 4 + 256 * i);
                    const f32x4 f = (f32x4){bflo(fb[q][i].x), bfhi(fb[q][i].x), bflo(fb[q][i].y), bfhi(fb[q][i].y)};
                    const f32x4 m = (f32x4){bflo(mb[q][i].x), bfhi(mb[q][i].x), bflo(mb[q][i].y), bfhi(mb[q][i].y)};
                    *(f32x4*)(P.out + (size_t)rows[q] * 1024 + lane * 4 + 256 * i) = (xv[q][i] + m * sc1 * g1) + f * sc * g; } } }
    }
    for (int row = MP + bid * 8 + wid; row < MT; row += nb * 8) {
        float* xo = P.out + (size_t)row * 1024;
        f32x4 fx[4]; float sc;
        if (row < MP) {
#pragma unroll
            for (int i = 0; i < 4; ++i) { const u32x2 fb = *(const u32x2*)(F + (size_t)row * 1024 + lane * 4 + 256 * i); fx[i] = (f32x4){bflo(fb.x), bfhi(fb.x), bflo(fb.y), bfhi(fb.y)}; }
            sc = rsqrtf(rss[row] * (1.f / 1024.f) + 1e-6f);
        } else {
            const float* fs = (const float*)(P.ws + FS_O) + (size_t)(row - MP) * 1024; float s0 = 0.f;
#pragma unroll
            for (int i = 0; i < 4; ++i) { fx[i] = *(const f32x4*)(fs + lane * 4 + 256 * i); s0 += fx[i].x * fx[i].x + fx[i].y * fx[i].y + fx[i].z * fx[i].z + fx[i].w * fx[i].w; }
            sc = rsqrtf(wave_sum(s0) * (1.f / 1024.f) + 1e-6f);
        }
#pragma unroll
        for (int i = 0; i < 4; ++i) {
            const int c = lane * 4 + 256 * i;
            f32x4 xv = *(const f32x4*)(xo + c); const f32x4 g = *(const f32x4*)(P.in[I_NPOF] + c);
            xv = xv + fx[i] * sc * g;
            *(f32x4*)(xo + c) = xv;
        }
    }
}

template <int NST, int NP, class Epi>
__device__ __forceinline__ void sample_gemm(LAS unsigned char* ldsb, int bid, int nb, const bf16_t* A0, const bf16_t* Bt0, const bf16_t* A1, const bf16_t* Bt1, const Epi& epi) {
    constexpr int K = NST * 32 * 8;
    const int tid = TID(), wid = tid >> 6, lane = tid & 63, fr = lane & 15, fq = lane >> 4;
    LAS float* red = (LAS float*)ldsb;
    for (int it = bid; it < 256; it += nb) {
        const int row0 = 32 * (it & 3), col0 = 16 * (it >> 2), kb = wid * (K / 8) + fq * 8;
        f32x4 acc[NP][2];
#pragma unroll
        for (int p = 0; p < NP; ++p) {
            acc[p][0] = (f32x4){0.f, 0.f, 0.f, 0.f}; acc[p][1] = acc[p][0];
            const bf16_t* Ap = (p ? A1 : A0) + (size_t)(MP + row0 + fr) * K + kb;
            const bf16_t* Bp = (p ? Bt1 : Bt0) + (size_t)(col0 + fr) * K + kb;
            bf16x8 a0[NST], a1[NST], bb[NST];
#pragma unroll
            for (int s_ = 0; s_ < NST; ++s_) { a0[s_] = *(const bf16x8*)(Ap + s_ * 32); a1[s_] = *(const bf16x8*)(Ap + (size_t)16 * K + s_ * 32); bb[s_] = *(const bf16x8*)(Bp + s_ * 32); }
#pragma unroll
            for (int s_ = 0; s_ < NST; ++s_) { acc[p][0] = __builtin_amdgcn_mfma_f32_16x16x32_bf16(a0[s_], bb[s_], acc[p][0], 0, 0, 0); acc[p][1] = __builtin_amdgcn_mfma_f32_16x16x32_bf16(a1[s_], bb[s_], acc[p][1], 0, 0, 0); }
        }
#pragma unroll
        for (int p = 0; p < NP; ++p)
#pragma unroll
            for (int t = 0; t < 2; ++t) *(LAS f32x4*)(red + ((((wid * NP + p) * 2 + t) * 64) + lane) * 4) = acc[p][t];
        __syncthreads();
        if (wid < 2) {
            f32x4 r[NP];
#pragma unroll
            for (int p = 0; p < NP; ++p) { r[p] = (f32x4){0.f, 0.f, 0.f, 0.f};
#pragma unroll
                for (int w = 0; w < 8; ++w) r[p] += *(const LAS f32x4*)(red + ((((w * NP + p) * 2 + wid) * 64) + lane) * 4); }
#pragma unroll
            for (int i = 0; i < 4; ++i) epi(r, i, row0 + 16 * wid + fq * 4 + i, col0 + fr);
        }
        __syncthreads();
    }
}

#define XB_TMO      128
#define XB_XCNT(j)  (256  + 64 * (j))
#define XB_XSUB(j)  (1280 + 64 * (j))
#define XB_XGEN(j)  (2304 + 64 * (j))
#define XB_TOP      3328
#define XB_TOPGEN   3392
#define XCD_BAR_WORDS 3456
#define XB_SPIN_CAP (1u << 18)
__device__ __forceinline__ unsigned xb_ld(unsigned* p)              { return __hip_atomic_load(p, __ATOMIC_RELAXED, __HIP_MEMORY_SCOPE_AGENT); }
__device__ __forceinline__ unsigned xb_add(unsigned* p, unsigned v) { return __hip_atomic_fetch_add(p, v, __ATOMIC_RELAXED, __HIP_MEMORY_SCOPE_AGENT); }
__device__ __forceinline__ unsigned xb_xcc_id() { return (unsigned)__builtin_amdgcn_s_getreg((3 << 11) | 20) & 0xFu; }
#define XB_SPIN(cond, bar) do { unsigned _sp = 0; while (cond) { __builtin_amdgcn_s_sleep(1); \
    if ((++_sp & 255u) == 0u) { if (xb_ld(&(bar)[XB_TMO])) break; if (_sp > XB_SPIN_CAP) { atomicAdd(&(bar)[XB_TMO], 1u); break; } } } } while (0)
struct XcdBarrier { unsigned* bar; unsigned x; volatile LAS unsigned* st; };
__device__ __forceinline__ XcdBarrier xcd_barrier_post(unsigned* bar, volatile LAS unsigned* st) {
    XcdBarrier b; b.bar = bar; b.x = xb_xcc_id(); b.st = st;
    if (threadIdx.x == 0) (void)xb_add(&bar[XB_XCNT(b.x)], 1u);
    return b;
}
__device__ __forceinline__ void xcd_barrier_complete(unsigned* bar, unsigned x, unsigned& nloc, unsigned& nx) {
    const unsigned G = gridDim.x * gridDim.y * gridDim.z;
    unsigned sum, cnt, mine, sp = 0u;
    for (;;) {
        sum = 0u; cnt = 0u; mine = 0u;
#pragma unroll
        for (unsigned j = 0; j < 16; ++j) { const unsigned c = xb_ld(&bar[XB_XCNT(j)]); sum += c; cnt += (c > 0u) ? 1u : 0u; mine = (j == x) ? c : mine; }
        if (sum == G) break;
        __builtin_amdgcn_s_sleep(1);
        if ((++sp & 255u) == 0u) { if (xb_ld(&bar[XB_TMO])) break; if (sp > XB_SPIN_CAP) { atomicAdd(&bar[XB_TMO], 1u); break; } }
    }
    nloc = mine > 0u ? mine : 1u; nx = cnt > 0u ? cnt : 1u;
}
__device__ __forceinline__ void xcd_barrier(const XcdBarrier& b) {
    asm volatile("s_waitcnt vmcnt(0)" ::: "memory");
    __syncthreads();
    if (TID() == 0) {
        unsigned* bar = b.bar;
        __builtin_amdgcn_s_waitcnt(0);
        unsigned nloc = b.st[0], nx = b.st[1];
        if (nloc == 0u) { xcd_barrier_complete(bar, b.x, nloc, nx); b.st[0] = nloc; b.st[1] = nx; }
        const unsigned old = xb_add(&bar[XB_XSUB(b.x)], 1u);
        const unsigned gen = old / nloc;
        if (old + 1u == (gen + 1u) * nloc) {
            __builtin_amdgcn_fence(__ATOMIC_RELEASE, "agent");
            asm volatile("s_waitcnt vmcnt(0)" ::: "memory");
            const unsigned og = xb_add(&bar[XB_TOP], 1u);
            const unsigned tg = og / nx;
            if (og + 1u == (tg + 1u) * nx) xb_add(&bar[XB_TOPGEN], 1u);
            else XB_SPIN(xb_ld(&bar[XB_TOPGEN]) == tg, bar);
            __builtin_amdgcn_fence(__ATOMIC_ACQUIRE, "agent");
            xb_add(&bar[XB_XGEN(b.x)], 1u);
            asm volatile("s_waitcnt vmcnt(0)" ::: "memory");
        } else {
            XB_SPIN(xb_ld(&bar[XB_XGEN(b.x)]) == gen, bar);
            __builtin_amdgcn_fence(__ATOMIC_ACQUIRE, "agent");
            asm volatile("s_waitcnt vmcnt(0)" ::: "memory");
        }
    }
    __syncthreads();
}

constexpr int NPHASE = 13;
__device__ __forceinline__ void run_phase(const Params& P, const int ph, LAS unsigned char* lds, int bid, int nb) {
    asm volatile("" : "+s"(bid), "+s"(nb));
    Sched S;
#ifdef PROBE_TS
#define TSACC(S_) (S_).tsacc = (unsigned long long*)(P.ws + TS_O) + 48 + ph
#else
#define TSACC(S_) do { } while (0)
#endif
    switch (ph) {
    case 0: phase0(P, lds, bid, nb); break;
    case 1: { S.init(P.ws + XN_O, P.ws + W_IN_T, nullptr, nullptr, MPAD, INC, 1024, nb, bid, 0); TSACC(S); EpiStore E{wsbw(P, PROJ_O), INC, nullptr}; gemm_phase(lds, S, 1024, E); } break;
    case 2: phase_b0(P, bid, nb); break;
    case 3: { S.init((unsigned char*)P.out + LA_O, P.ws + W_LORA_T, nullptr, nullptr, MPAD, 1536, 256, nb, bid, 0); TSACC(S); EpiLora E{&P}; gemm_phase(lds, S, 256, E);
              S.init((unsigned char*)P.out + XC_O, P.ws + W_LRUG_T, nullptr, nullptr, MPAD, 1024, 512, nb, (bid + nb / 2 - 8) % nb, 0); TSACC(S); EpiLru E2{&P}; gemm_phase(lds, S, 512, E2); } break;
    case 4: if (nb == 256) { wkv_scan<true>(P, bid, (LAS float*)lds, bid, nb); __syncthreads(); }
            else { const int t_ = TID(); sample_wkv(P, bid * 8 + (t_ >> 6), nb * 8); sample_lru(P, bid * 512 + t_, nb * 512); lru_pass1(P, bid * 512 + t_, nb * 512);
                   for (int it = bid; it < 256; it += nb) { wkv_scan<false>(P, it, (LAS float*)lds, bid, nb); __syncthreads(); } }
            break;
    case 5: lru_pass2(P, bid, nb); phase_za(P, bid, nb); break;
    case 6: { { const bf16_t* proj = wsb(P, PROJ_O); bf16_t* O = wsbw(P, MIXIN_O);
                auto epi = [&](const f32x4 (&r)[2], int i, int row, int col) { const bf16_t* gp = proj + (size_t)(MP + row) * INC + 2304 + col;
                    O[(size_t)(MP + row) * 1024 + col] = f2bf(sigm(bf1(gp[0])) * r[0][i] + sigm(bf1(gp[1024])) * r[1][i]); };
                sample_gemm<2, 2>(lds, bid, nb, outb(P, ZA_O), wsb(P, W_A_T), outb(P, HS_O), wsb(P, W_B_T), epi); }
              S.init((unsigned char*)P.out + ZA_O, P.ws + W_A_T, (unsigned char*)P.out + HS_O, P.ws + W_B_T, MP, 1024, 512, nb, bid, 1); TSACC(S); EpiMix E{&P}; gemm_phase(lds, S, 512, E); } break;
    case 7: { { float* O = (float*)(P.ws + MIXS_O); auto epi = [&](const f32x4 (&r)[1], int i, int row, int col) { O[(size_t)row * 1024 + col] = r[0][i]; };
                sample_gemm<4, 1>(lds, bid, nb, wsb(P, MIXIN_O), wsb(P, W_O_T), nullptr, nullptr, epi); }
              S.init(P.ws + MIXIN_O, P.ws + W_O_T, nullptr, nullptr, MP, 1024, 1024, nb, bid, 0); TSACC(S); EpiStore E{wsbw(P, MIX_O), 1024, (float*)(P.ws + ROWSS1)}; gemm_phase(lds, S, 1024, E); } break;
    case 8: phase_e(P, bid, nb); break;
    case 9: { S.init(P.ws + HN_O, P.ws + W_UP_T, nullptr, nullptr, MPAD, DFF2, 1024, nb, bid, 0); TSACC(S); EpiUp E{&P}; gemm_phase(lds, S, 1024, E); } break;
    case 10: phase_f2(P, bid, nb); break;
    case 11: { { float* O = (float*)(P.ws + FS_O); auto epi = [&](const f32x4 (&r)[1], int i, int row, int col) { O[(size_t)row * 1024 + col] = r[0][i]; };
                 sample_gemm<11, 1>(lds, bid, nb, wsb(P, ACT_O), wsb(P, W_DN_T), nullptr, nullptr, epi); }
               S.init(P.ws + ACT_O, P.ws + W_DN_T, nullptr, nullptr, MP, 1024, DFF, nb, bid, 0); TSACC(S); EpiStore E{wsbw(P, F_O), 1024, (float*)(P.ws + ROWSS2)}; gemm_phase(lds, S, DFF, E); } break;
    case 12: phase_h(P, bid, nb); break;
    }
}

template <int PH0, int PH1>
__global__ void __launch_bounds__(512, 2) mega(Params P) {
    extern __shared__ __attribute__((aligned(16))) unsigned char shm[];
    LAS unsigned char* lds = (LAS unsigned char*)shm;
    cg::grid_group grid = cg::this_grid();
    volatile LAS unsigned* xbst = (volatile LAS unsigned*)(lds + 131072);
    if (threadIdx.x == 0) { xbst[0] = 0u; xbst[1] = 0u; }
    __syncthreads();
    const XcdBarrier xb = xcd_barrier_post((unsigned*)(P.ws + BAR_O), xbst);
    if (gridDim.y == 0x7fffffffu) grid.sync();
#define MK_PHASE(ph) do { if constexpr ((ph) >= PH0 && (ph) < PH1) { \
          \
        const __attribute__((address_space(4))) Params* kp = (const __attribute__((address_space(4))) Params*)__builtin_amdgcn_kernarg_segment_ptr(); \
        asm volatile("" : "+s"(kp)); \
        if ((ph) == 0) { if (blockIdx.x == 0 && threadIdx.x < 64) ((unsigned long long*)(kp->ws + TS_O))[threadIdx.x] = 0ull; __syncthreads(); MARK(*kp, 0); } \
        run_phase(*(const Params*)kp, (ph), lds, blockIdx.x, gridDim.x); MARK(*kp, 2 * (ph) + 1); \
        if constexpr ((ph) + 1 < PH1) { xcd_barrier(xb); MARK(*kp, 2 * (ph) + 2); } } } while (0)
#ifdef DUP_PHASE
#define MK_DUP(ph) do { if constexpr ((ph) == DUP_PHASE) { const __attribute__((address_space(4))) Params* kp = (const __attribute__((address_space(4))) Params*)__builtin_amdgcn_kernarg_segment_ptr(); \
        asm volatile("" : "+s"(kp)); run_phase(*(const Params*)kp, (ph), lds, blockIdx.x, gridDim.x); grid.sync(); } } while (0)
#else
#define MK_DUP(ph) do { } while (0)
#endif
    MK_DUP(0); MK_PHASE(0); MK_DUP(1); MK_PHASE(1); MK_DUP(2); MK_PHASE(2); MK_DUP(3); MK_PHASE(3); MK_DUP(4); MK_PHASE(4); MK_PHASE(5); MK_DUP(6); MK_PHASE(6);
    MK_PHASE(7); MK_DUP(8); MK_PHASE(8); MK_DUP(9); MK_PHASE(9); MK_DUP(10); MK_PHASE(10); MK_PHASE(11); MK_PHASE(12);
#undef MK_PHASE
#ifdef PROBE_TS
    if (blockIdx.x == 0 && threadIdx.x == 0) {
        const unsigned long long* ts = (const unsigned long long*)(P.ws + TS_O);
        auto val = [&](int a, int b) -> unsigned long long { unsigned long long v = (a >= 48) ? ts[a] : ts[b] - ts[a]; v /= (unsigned long long)PQ; return v > 63ull ? 63ull : v; };
        const unsigned long long w = 2000ull * val(PSEL1A, PSEL1B) + 128000ull * val(PSEL2A, PSEL2B);
        const unsigned long long t0 = __builtin_amdgcn_s_memrealtime();
        while (__builtin_amdgcn_s_memrealtime() - t0 < w) __builtin_amdgcn_s_sleep(8);
    }
#endif
}

template <int PH0, int PH1>
static void launch_range(const Params& p, hipStream_t stream) {
    static int grid_blocks = 0;
    const void* fn = (const void*)mega<PH0, PH1>;
    if (!grid_blocks) {
        (void)hipFuncSetAttribute(fn, hipFuncAttributeMaxDynamicSharedMemorySize, LDS_BYTES);
        int dev = 0, cus = 0, per_cu = 0;
        (void)hipGetDevice(&dev);
        (void)hipDeviceGetAttribute(&cus, hipDeviceAttributeMultiprocessorCount, dev);
        (void)hipOccupancyMaxActiveBlocksPerMultiprocessor(&per_cu, mega<PH0, PH1>, 512, LDS_BYTES);
        if (per_cu != 1) fprintf(stderr, "note: occupancy query says %d blocks/CU; using 1\n", per_cu);
        grid_blocks = cus;
        if (per_cu < 1) grid_blocks = 0;
    }
    if (!grid_blocks) { fprintf(stderr, "kernel not launchable\n"); return; }
    Params pl = p;
    void* args[] = {&pl};
    hipError_t e = hipLaunchCooperativeKernel(fn, dim3(grid_blocks), dim3(512), args, LDS_BYTES, stream);
    if (e != hipSuccess) fprintf(stderr, "cooperative launch failed: %s (grid %d)\n", hipGetErrorString(e), grid_blocks);
}

extern "C" void kernel_launch(void* const* d_in, const int* in_sizes, int n_in, void* d_out, int out_size, void* d_ws, size_t ws_size, hipStream_t stream) {
    if (ws_size < WS_NEED) { fprintf(stderr, "workspace too small: %zu < %zu\n", ws_size, (size_t)WS_NEED); return; }
    Params p{};
    for (int i = 0; i < 37; ++i) p.in[i] = (const float*)d_in[i];
    p.out = (float*)d_out; p.ws = (unsigned char*)d_ws;
    (void)hipMemsetAsync((unsigned char*)d_ws + BAR_O, 0, XCD_BAR_WORDS * sizeof(unsigned), stream);
#if ONE_LAUNCH
    launch_range<0, NPHASE>(p, stream);
#else
    launch_range<0, 1>(p, stream); launch_range<1, 2>(p, stream); launch_range<2, 3>(p, stream); launch_range<3, 4>(p, stream);
    launch_range<4, 5>(p, stream); launch_range<5, 6>(p, stream); launch_range<6, 7>(p, stream); launch_range<7, 8>(p, stream);
    launch_range<8, 9>(p, stream); launch_range<9, 10>(p, stream); launch_range<10, 11>(p, stream); launch_range<11, 12>(p, stream);
    launch_range<12, 13>(p, stream);
#endif
}
```

```cpp
#include <hip/hip_runtime.h>
#include <hip/hip_cooperative_groups.h>
#include <cstdio>
namespace cg = cooperative_groups;

#ifndef ONE_LAUNCH
#define ONE_LAUNCH 1
#endif

#define LAS __attribute__((address_space(3)))
typedef unsigned short bf16_t;
typedef short bf16x8 __attribute__((ext_vector_type(8)));
typedef float f32x4 __attribute__((ext_vector_type(4)));
typedef unsigned u32x4 __attribute__((ext_vector_type(4)));
typedef unsigned u32x2 __attribute__((ext_vector_type(2)));

constexpr int MP = 16384, MT = 16512, MPAD = 16640;
constexpr int DM = 1024, RP = 1792, LW = 512, INC = 4352, DFF = 2816, DFF2 = 5632;
constexpr size_t O_YP = 0, O_YS = 16777216, O_PSHIFT = 16908288, O_PWKV = 16922624, O_PLCONV = 17184768, O_PLH = 17197056,
                 O_PFCONV = 17201152, O_SSHIFT = 17291264, O_SWKV = 17520640, O_SLCONV = 21714944, O_SLH = 21911552, O_SFCONV = 21977088;
constexpr size_t W_IN_T = 0, W_UP_T = 8912896, W_DN_T = 20447232, W_O_T = 26214400, W_A_T = 28311552, W_B_T = 29360128,
                 W_LRUG_T = 30408704, W_LORA_T = 31457280, ROWSS1 = 32243712, ROWSS2 = 32310272;
constexpr size_t BASE1 = 33554432;
constexpr size_t PROJ_O = BASE1;
constexpr size_t R2 = BASE1 + 144834560;
constexpr size_t SZ512 = (size_t)MPAD * 512 * 2;
constexpr size_t SZ1024 = (size_t)MPAD * 1024 * 2;
constexpr size_t XN_O = R2, KK_O = R2, E_O = R2 + SZ512, ASIG_O = R2 + 2 * SZ512, G_O = R2 + 3 * SZ512, Y_O = R2 + 4 * SZ512;
constexpr size_t MIXIN_O = R2, MIX_O = BASE1, HN_O = R2 + SZ1024, ACT_O = BASE1 + SZ1024, STASH_O = ACT_O + (size_t)MPAD * DFF * 2, F_O = R2;
constexpr size_t CARRY_P = R2 + 5 * SZ512, CARRY_H = CARRY_P + 1048576, TS_O = CARRY_H + 1048576;
constexpr size_t BAR_O = TS_O + 1024;
constexpr size_t MIXS_O = BAR_O + 16384, FS_O = MIXS_O + 524288;
constexpr size_t BON_O = FS_O + 524288;
constexpr size_t WS_NEED = BON_O + (size_t)MT * 8 * 4;
static_assert(WS_NEED <= 268435456ull, "ws too big");
constexpr size_t SUP_O = STASH_O + 260ull * 4 * DFF2 * 4;
static_assert(SUP_O + 128ull * DFF2 * 4 <= HN_O, "stash overlaps hn");
constexpr size_t LA_O = 0, XC_O = 8519680, LLA_O = XC_O + SZ512, LU_O = LLA_O + SZ512;
constexpr size_t ZA_O = XC_O, HS_O = LU_O;
static_assert(LU_O + SZ512 <= (size_t)MT * 1024 * 4, "d_out scratch too big");

constexpr int LDS_BYTES = 131072 + 64;

struct Params {
    const float* in[37];
    float* out;
    unsigned char* ws;
};
enum { I_XP = 0, I_XS, I_SSHIFT, I_SWKV, I_SLCONV, I_SLH, I_SFCONV, I_NPM, I_NPOM, I_NPF, I_NPOF, I_WIN, I_MU, I_W0, I_WUP, I_A0, I_AUP, I_GUP,
       I_KK, I_KA, I_RK, I_LNW, I_LNB, I_WOUT, I_LCW, I_LCB, I_GXW, I_GXB, I_GAW, I_GAB, I_LAM, I_LWOUT, I_WO, I_FUP, I_FCW, I_FCB, I_FDN };

__device__ __forceinline__ int TID() { int t = threadIdx.x; asm volatile("" : "+v"(t)); return t; }
__device__ __forceinline__ float bflo(unsigned u) { return __uint_as_float(u << 16); }
__device__ __forceinline__ float bfhi(unsigned u) { return __uint_as_float(u & 0xffff0000u); }
__device__ __forceinline__ float bf1(bf16_t b) { return __uint_as_float(((unsigned)b) << 16); }
__device__ __forceinline__ unsigned pk2(float lo, float hi) { unsigned r; asm volatile("v_cvt_pk_bf16_f32 %0, %1, %2" : "=v"(r) : "v"(lo), "v"(hi)); return r; }
__device__ __forceinline__ bf16_t f2bf(float f) { return (bf16_t)(pk2(f, 0.f) & 0xffffu); }
__device__ __forceinline__ void unpack8(const u32x4 u, float (&o)[8]) {
    o[0] = bflo(u.x); o[1] = bfhi(u.x); o[2] = bflo(u.y); o[3] = bfhi(u.y); o[4] = bflo(u.z); o[5] = bfhi(u.z); o[6] = bflo(u.w); o[7] = bfhi(u.w);
}
__device__ __forceinline__ u32x4 pack8(const float (&v)[8]) { u32x4 w; w.x = pk2(v[0], v[1]); w.y = pk2(v[2], v[3]); w.z = pk2(v[4], v[5]); w.w = pk2(v[6], v[7]); return w; }
__device__ __forceinline__ void ld8bf(const bf16_t* p, float (&o)[8]) { unpack8(*(const u32x4*)p, o); }
__device__ __forceinline__ void ld8bf_nt(const bf16_t* p, float (&o)[8]) { unpack8(__builtin_nontemporal_load((const u32x4*)p), o); }
__device__ __forceinline__ void ld8f(const float* p, float (&o)[8]) { const f32x4 a = *(const f32x4*)p, b = *(const f32x4*)(p + 4); o[0] = a.x; o[1] = a.y; o[2] = a.z; o[3] = a.w; o[4] = b.x; o[5] = b.y; o[6] = b.z; o[7] = b.w; }
__device__ __forceinline__ void st8f(float* p, const float (&v)[8]) { *(f32x4*)p = (f32x4){v[0], v[1], v[2], v[3]}; *(f32x4*)(p + 4) = (f32x4){v[4], v[5], v[6], v[7]}; }
__device__ __forceinline__ float rcp_(float x) { return __builtin_amdgcn_rcpf(x); }
__device__ __forceinline__ float sigm(float x) { return rcp_(1.f + __expf(-x)); }
__device__ __forceinline__ float tanh_(float x) { return 1.f - 2.f * rcp_(1.f + __expf(2.f * x)); }
__device__ __forceinline__ float fma_s(float a, float b, float c) { float r; asm("v_fma_f32 %0, %1, %2, %3" : "=v"(r) : "v"(a), "v"(b), "v"(c)); return r; }
__device__ __forceinline__ float gelu_t(float x) { const float p = fmaf(x * x, -0.10294324f, -2.30220819f);
    return x * rcp_(1.f + __builtin_amdgcn_exp2f(p * x)); }
__device__ __forceinline__ float wave_sum(float v) { for (int o = 32; o; o >>= 1) v += __shfl_xor(v, o); return v; }
template <int CTRL> __device__ __forceinline__ float dppf(float x) { return __int_as_float(__builtin_amdgcn_update_dpp(0, __float_as_int(x), CTRL, 0xF, 0xF, true)); }
__device__ __forceinline__ float row16_sum(float x) {
    x += dppf<0xB1>(x);
    x += dppf<0x4E>(x);
    x += dppf<0x141>(x);
    x += dppf<0x140>(x);
    return x;
}
#ifdef USE_BPERM
__device__ __forceinline__ float ror1(float x) { const int l = threadIdx.x & 63; return __shfl(x, (l & 48) | ((l - 1) & 15)); }
__device__ __forceinline__ float ror2(float x) { const int l = threadIdx.x & 63; return __shfl(x, (l & 48) | ((l - 2) & 15)); }
#else
__device__ __forceinline__ float ror1(float x) { return dppf<0x121>(x); }
__device__ __forceinline__ float ror2(float x) { return dppf<0x122>(x); }
#endif

__device__ __forceinline__ const bf16_t* wsb(const Params& P, size_t off) { return (const bf16_t*)(P.ws + off); }
__device__ __forceinline__ bf16_t* wsbw(const Params& P, size_t off) { return (bf16_t*)(P.ws + off); }
__device__ __forceinline__ bf16_t* outb(const Params& P, size_t off) { return (bf16_t*)((unsigned char*)P.out + off); }

__device__ __forceinline__ void shifted8(const Params& P, int row, int col, float (&m)[8]) {
    const bf16_t* proj = wsb(P, PROJ_O);
    float p[8], pv[8], mu[8];
    ld8bf(proj + (size_t)row * INC + col, p);
    if (row >= MP) ld8f(P.in[I_SSHIFT] + (size_t)(row - MP) * RP + col, pv);
    else if ((row & 2047) == 0) { for (int i = 0; i < 8; ++i) pv[i] = 0.f; }
    else ld8bf(proj + (size_t)(row - 1) * INC + col, pv);
    ld8f(P.in[I_MU] + col, mu);
#pragma unroll
    for (int i = 0; i < 8; ++i) m[i] = p[i] + mu[i] * (pv[i] - p[i]);
}
__device__ __forceinline__ float shifted1(const Params& P, int row, int col) {
    const bf16_t* proj = wsb(P, PROJ_O);
    const float p = bf1(proj[(size_t)row * INC + col]);
    float pv;
    if (row >= MP) pv = P.in[I_SSHIFT][(size_t)(row - MP) * RP + col];
    else if ((row & 2047) == 0) pv = 0.f;
    else pv = bf1(proj[(size_t)(row - 1) * INC + col]);
    return p + P.in[I_MU][col] * (pv - p);
}

#ifndef PQ
#define PQ 600
#endif
#ifdef PROBE_TS
#define MARK(P_, i_) do { if (blockIdx.x == 0 && threadIdx.x == 0) ((unsigned long long*)((P_).ws + TS_O))[(i_)] = __builtin_amdgcn_s_memrealtime(); } while (0)
#else
#define MARK(P_, i_) do { } while (0)
#endif
constexpr int BM = 256, BK = 64, HALF = 128, HTB = HALF * BK * 2, NXCD = 8, WGM = 8;
__device__ __forceinline__ int lds_byte(int r, int c) { const int st = (r >> 4) * 2 + (c >> 5), rr = r & 15, cc = c & 31, ob = rr * 64 + cc * 2; return st * 1024 + (ob ^ (((ob >> 9) & 1) << 5)); }
__device__ __forceinline__ void stage_rc(int b, int& R, int& C) { const int st = b / 1024, sb = b % 1024, swz = sb ^ (((sb >> 9) & 1) << 5); R = (st >> 1) * 16 + swz / 64; C = (st & 1) * 32 + (swz % 64) / 2; }
__device__ __forceinline__ int perm32(int rho) { const int n = rho >> 4, i = rho & 15; return 8 * (i >> 2) + 4 * n + (i & 3); }

struct Unit { int pm, pn, kind; };
struct Sched {
    const char* A0; const char* B0; const char* A1; const char* B1;
    __device__ __forceinline__ const char* pa(int kind) const { return kind ? A1 : A0; }
    __device__ __forceinline__ const char* pb(int kind) const { return kind ? B1 : B0; }
    unsigned long long* tsacc;
    int nM, nN, nwg, G, c, sshift;
    size_t tstep;
    __device__ __forceinline__ void init(const void* a0, const void* b0, const void* a1, const void* b1, int M, int N, int K, int G_, int c_, int ss) {
        A0 = (const char*)a0; B0 = (const char*)b0; A1 = (const char*)a1; B1 = (const char*)b1;
        nM = M / BM; nN = N / BM; nwg = nM * nN; G = G_; c = c_; sshift = ss; tstep = (size_t)BM * K * 2; tsacc = nullptr;
    }
    __device__ __forceinline__ bool next(int i, Unit& u) const {
        const int j = i >> sshift; u.kind = i - (j << sshift);
        const long L = (long)j * G + c; if (L >= nwg) return false;
        int wgid = (int)L; { const int q = nwg / NXCD, r = nwg % NXCD, xcd = wgid % NXCD, off = wgid / NXCD; wgid = (xcd < r ? xcd * (q + 1) : r * (q + 1) + (xcd - r) * q) + off; }
        const int nig = WGM * nN, gid = wgid / nig, fm = gid * WGM, gsz = (nM - fm) < WGM ? (nM - fm) : WGM;
        u.pm = fm + ((wgid % nig) % gsz); u.pn = (wgid % nig) / gsz; return true;
    }
};

template <class Epi>
__device__ __forceinline__ void gemm_phase(LAS unsigned char* lds, const Sched& S, const int K, const Epi& E) {
    const int tid = TID(), wid = __builtin_amdgcn_readfirstlane(tid >> 6), lane = tid & 63, wr = wid >> 2, wc = wid & 3, fr = lane & 15, fq = lane >> 4;
    const int nt = K / BK;
    unsigned voffA[2], voffB[2];
#pragma unroll
    for (int i = 0; i < 2; ++i) { int R, C; stage_rc(tid * 16 + i * 8192, R, C); const int Rb = (R & ~31) + perm32(R & 31);
        voffA[i] = (unsigned)(R * K + C) * 2u; voffB[i] = (unsigned)(Rb * K + C) * 2u; }
    const size_t kstep = (size_t)(BK * 2);
    const size_t hstep = (size_t)HALF * K * 2;
    const unsigned ldsw = (unsigned)wid * 1024u;
    const int aoff = lds_byte(wr * 64 + fr, fq * 8), boff = lds_byte(wc * 32 + fr, fq * 8);
#define PG8_SA(b, h) (((b) * 2 + (h)) * HTB)
#define PG8_SB(b, h) ((4 + (b) * 2 + (h)) * HTB)
#define PG8_STAGE(bufoff, gbase, voff) do { _Pragma("unroll") for (int _i = 0; _i < 2; ++_i) \
        __builtin_amdgcn_global_load_lds((const unsigned*)((const char*)(gbase) + (voff)[_i]), (LAS unsigned*)(lds + (bufoff) + ldsw + _i * 8192), 16, 0, 0); } while (0)
#define PG8_LDA(dst, b, h) do { _Pragma("unroll") for (int m = 0; m < 4; ++m) _Pragma("unroll") for (int k = 0; k < 2; ++k) dst[m][k] = *(const LAS bf16x8*)(lds + PG8_SA(b, h) + aoff + m * 2048 + k * 1024); } while (0)
#define PG8_LDB(dst, b, h) do { _Pragma("unroll") for (int n = 0; n < 2; ++n) _Pragma("unroll") for (int k = 0; k < 2; ++k) dst[n][k] = *(const LAS bf16x8*)(lds + PG8_SB(b, h) + boff + n * 2048 + k * 1024); } while (0)
#define PG8_MMA(ai, bj, At, Bt) do { __builtin_amdgcn_s_setprio(1); _Pragma("unroll") for (int m = 0; m < 4; ++m) _Pragma("unroll") for (int n = 0; n < 2; ++n) _Pragma("unroll") for (int k = 0; k < 2; ++k) \
        acc[ai][bj][m][n] = __builtin_amdgcn_mfma_f32_16x16x32_bf16(Bt[n][k], At[m][k], acc[ai][bj][m][n], 0, 0, 0); __builtin_amdgcn_s_setprio(0); } while (0)
#define PG8_WAIT_V(n) asm volatile("s_waitcnt vmcnt(" #n ")" ::: "memory")
#define PG8_WAIT_L(n) asm volatile("s_waitcnt lgkmcnt(" #n ")" ::: "memory")
#define PG8_BAR __builtin_amdgcn_s_barrier()
#define PG8_SCHED __builtin_amdgcn_sched_barrier(0)
    Unit cur, nxt; int ui = 0;
    if (!S.next(0, cur)) return;
#ifdef STAGGER_TICKS
    { const unsigned long long t0_ = __builtin_amdgcn_s_memrealtime(), dl_ = (unsigned long long)((S.c >> 3) & 3) * STAGGER_TICKS;
      while (__builtin_amdgcn_s_memrealtime() - t0_ < dl_) __builtin_amdgcn_s_sleep(4); }
#endif
    f32x4 acc[2][2][4][2];
#pragma unroll
    for (int a = 0; a < 2; ++a)
#pragma unroll
        for (int b = 0; b < 2; ++b)
#pragma unroll
            for (int m = 0; m < 4; ++m)
#pragma unroll
                for (int n = 0; n < 2; ++n) acc[a][b][m][n] = (f32x4){0.f, 0.f, 0.f, 0.f};
    bf16x8 At[4][2], B0[2][2], B1[2][2];
    const char* cA = S.pa(cur.kind) + (size_t)cur.pm * S.tstep; const char* cB = S.pb(cur.kind) + (size_t)cur.pn * S.tstep;
    PG8_STAGE(PG8_SB(0, 0), cB, voffB); PG8_STAGE(PG8_SA(0, 0), cA, voffA); PG8_STAGE(PG8_SB(0, 1), cB + hstep, voffB); PG8_STAGE(PG8_SA(0, 1), cA + hstep, voffA);
    if (wr == 1) PG8_BAR;
    PG8_WAIT_V(4); PG8_BAR;
    PG8_STAGE(PG8_SB(1, 0), cB + kstep, voffB); PG8_STAGE(PG8_SA(1, 0), cA + kstep, voffA); PG8_STAGE(PG8_SB(1, 1), cB + hstep + kstep, voffB);
    PG8_WAIT_V(6); PG8_BAR;
    for (;;) {
        const bool has_next = S.next(ui + 1, nxt);
        const char* nA = has_next ? S.pa(nxt.kind) + (size_t)nxt.pm * S.tstep : cA; const char* nB = has_next ? S.pb(nxt.kind) + (size_t)nxt.pn * S.tstep : cB;
        for (int t = 0; t < nt; t += 2) {
            const bool last = (t == nt - 2);
            const char* a1 = cA + (size_t)(t + 1) * kstep;
            const char* a2 = last ? nA : cA + (size_t)(t + 2) * kstep; const char* b2 = last ? nB : cB + (size_t)(t + 2) * kstep;
            const char* a3 = a2 + kstep; const char* b3 = b2 + kstep;
            PG8_LDB(B0, 0, 0); PG8_SCHED; PG8_LDA(At, 0, 0); PG8_STAGE(PG8_SA(1, 1), a1 + hstep, voffA);
            PG8_WAIT_L(8); PG8_BAR; PG8_WAIT_L(0); PG8_MMA(0, 0, At, B0); PG8_BAR; PG8_SCHED;
            PG8_LDB(B1, 0, 1); PG8_STAGE(PG8_SB(0, 0), b2, voffB);
            PG8_BAR; PG8_WAIT_L(0); PG8_MMA(0, 1, At, B1); PG8_BAR;
            PG8_LDA(At, 0, 1); PG8_STAGE(PG8_SA(0, 0), a2, voffA);
            PG8_BAR; PG8_WAIT_L(0); PG8_MMA(1, 0, At, B0); PG8_BAR; PG8_SCHED;
            PG8_STAGE(PG8_SB(0, 1), b2 + hstep, voffB);
            PG8_WAIT_V(6); PG8_BAR; PG8_MMA(1, 1, At, B1); PG8_BAR;
            PG8_LDB(B0, 1, 0); PG8_SCHED; PG8_LDA(At, 1, 0); PG8_STAGE(PG8_SA(0, 1), a2 + hstep, voffA);
            PG8_WAIT_L(8); PG8_BAR; PG8_WAIT_L(0); PG8_MMA(0, 0, At, B0); PG8_BAR; PG8_SCHED;
            PG8_LDB(B1, 1, 1); PG8_STAGE(PG8_SB(1, 0), b3, voffB);
            PG8_BAR; PG8_WAIT_L(0); PG8_MMA(0, 1, At, B1); PG8_BAR;
            PG8_LDA(At, 1, 1); PG8_STAGE(PG8_SA(1, 0), a3, voffA);
            PG8_BAR; PG8_WAIT_L(0); PG8_MMA(1, 0, At, B0); PG8_BAR; PG8_SCHED;
            PG8_STAGE(PG8_SB(1, 1), b3 + hstep, voffB);
            PG8_WAIT_V(6); PG8_BAR; PG8_MMA(1, 1, At, B1); PG8_BAR;
        }
#ifdef PROBE_EPI
        unsigned long long te0_ = 0; if (S.tsacc && blockIdx.x == 0 && threadIdx.x == 0) te0_ = __builtin_amdgcn_s_memrealtime();
#endif
        const bool keep = E(acc, cur, wr, wc, fr, fq);
#ifdef PROBE_EPI
        if (S.tsacc && blockIdx.x == 0 && threadIdx.x == 0) { asm volatile("s_waitcnt vmcnt(0)" ::: "memory"); *S.tsacc += __builtin_amdgcn_s_memrealtime() - te0_; }
#endif
        if (!has_next) break;
        if (!keep) {
#pragma unroll
            for (int a = 0; a < 2; ++a)
#pragma unroll
                for (int b = 0; b < 2; ++b)
#pragma unroll
                    for (int m = 0; m < 4; ++m)
#pragma unroll
                        for (int n = 0; n < 2; ++n) acc[a][b][m][n] = (f32x4){0.f, 0.f, 0.f, 0.f};
        }
        cur = nxt; cA = nA; cB = nB; ++ui;
    }
    PG8_WAIT_V(0);
    if (wr == 0) PG8_BAR;
    PG8_BAR;
#undef PG8_SA
#undef PG8_SB
#undef PG8_STAGE
#undef PG8_LDA
#undef PG8_LDB
#undef PG8_MMA
#undef PG8_WAIT_V
#undef PG8_WAIT_L
#undef PG8_BAR
#undef PG8_SCHED
}

typedef f32x4 Acc[2][2][4][2];

struct EpiStore {
    bf16_t* O; int ldc; float* rowss;
    __device__ __forceinline__ bool operator()(Acc& acc, const Unit& u, int wr, int wc, int fr_, int fq_) const {
        int fr = fr_, fq = fq_; asm volatile("" : "+v"(fr), "+v"(fq));
        const int row0 = u.pm * BM + wr * 64 + fr, col0 = u.pn * BM + wc * 32 + 8 * fq;
#pragma unroll
        for (int ai = 0; ai < 2; ++ai)
#pragma unroll
            for (int m = 0; m < 4; ++m) {
                const int row = row0 + ai * HALF + m * 16;
                bf16_t* rowp = O + (size_t)row * ldc + col0;
                float ss = 0.f;
#pragma unroll
                for (int bj = 0; bj < 2; ++bj) {
                    const f32x4 v0 = acc[ai][bj][m][0], v1 = acc[ai][bj][m][1];
                    u32x4 w; w.x = pk2(v0[0], v0[1]); w.y = pk2(v0[2], v0[3]); w.z = pk2(v1[0], v1[1]); w.w = pk2(v1[2], v1[3]);
                    *(u32x4*)(rowp + bj * HALF) = w;
                    ss += v0[0] * v0[0] + v0[1] * v0[1] + v0[2] * v0[2] + v0[3] * v0[3] + v1[0] * v1[0] + v1[1] * v1[1] + v1[2] * v1[2] + v1[3] * v1[3];
                }
                if (rowss) { ss += __shfl_xor(ss, 16); ss += __shfl_xor(ss, 32); if (fq == 0) atomicAdd(rowss + row, ss); }
                __builtin_amdgcn_sched_barrier(0);
            }
        return false;
    }
};

struct EpiLora {
    const Params* P;
    __device__ __forceinline__ bool operator()(Acc& acc, const Unit& u, int wr, int wc, int fr_, int fq_) const {
        int fr = fr_, fq = fq_; asm volatile("" : "+v"(fr), "+v"(fq));
        const int sec = u.pn >> 1, cb = (u.pn & 1) * 256 + wc * 32 + 8 * fq, row0 = u.pm * BM + wr * 64 + fr;
        bf16_t* O = wsbw(*P, sec == 0 ? E_O : (sec == 1 ? ASIG_O : G_O));
        const float* bias = sec == 0 ? P->in[I_W0] : P->in[I_A0];
#pragma unroll
        for (int bj = 0; bj < 2; ++bj) {
            const int c = cb + bj * HALF;
            float bv[8];
            if (sec < 2) ld8f(bias + c, bv); else { for (int i = 0; i < 8; ++i) bv[i] = 0.f; }
#pragma unroll
            for (int ai = 0; ai < 2; ++ai)
#pragma unroll
                for (int m = 0; m < 4; ++m) {
                    int row = row0 + ai * HALF + m * 16; asm volatile("" : "+v"(row));
                    float v[8];
#pragma unroll
                    for (int i = 0; i < 8; ++i) v[i] = acc[ai][bj][m][i >> 2][i & 3] + bv[i];
                    if (sec == 0) { for (int i = 0; i < 8; ++i) v[i] = 0.6065306597f * sigm(v[i]); }
                    else if (sec == 1) { for (int i = 0; i < 8; ++i) v[i] = sigm(v[i]); }
                    *(u32x4*)(O + (size_t)row * 512 + c) = pack8(v);
                    __builtin_amdgcn_sched_barrier(0);
                }
        }
        return false;
    }
};

struct EpiLru {
    const Params* P;
    __device__ __forceinline__ bool operator()(Acc& acc, const Unit& u, int wr, int wc, int fr_, int fq_) const {
        int fr = fr_, fq = fq_; asm volatile("" : "+v"(fr), "+v"(fq));
        const int ch = u.pn * 128 + wc * 32 + 8 * fq, row0 = u.pm * BM + wr * 64 + fr;
        float gxb[8], gab[8], sp[8];
        ld8f(P->in[I_GXB] + ch, gxb); ld8f(P->in[I_GAB] + ch, gab); ld8f(P->in[I_LAM] + ch, sp);
#pragma unroll
        for (int i = 0; i < 8; ++i) sp[i] = -8.f * log1pf(__expf(-sp[i]));
        const bf16_t* XC = outb(*P, XC_O);
        bf16_t* LLA = outb(*P, LLA_O); bf16_t* LU = outb(*P, LU_O);
#pragma unroll
        for (int ai = 0; ai < 2; ++ai) {
            u32x4 xcr[4];
#pragma unroll
            for (int m = 0; m < 4; ++m) xcr[m] = *(const u32x4*)(XC + (size_t)(row0 + ai * HALF + m * 16) * 512 + ch);
#pragma unroll
            for (int m = 0; m < 4; ++m) {
                int row = row0 + ai * HALF + m * 16; asm volatile("" : "+v"(row));
                float xc[8], la[8], uu[8];
                unpack8(xcr[m], xc);
#pragma unroll
                for (int i = 0; i < 8; ++i) {
                    const float gx = sigm(acc[ai][0][m][i >> 2][i & 3] + gxb[i]);
                    const float ga = sigm(acc[ai][1][m][i >> 2][i & 3] + gab[i]);
                    la[i] = ga * sp[i];
                    uu[i] = __builtin_amdgcn_sqrtf(fmaxf(1.f - __expf(2.f * la[i]), 0.f)) * gx * xc[i];
                }
                *(u32x4*)(LLA + (size_t)row * 512 + ch) = pack8(la);
                *(u32x4*)(LU + (size_t)row * 512 + ch) = pack8(uu);
            }
            __builtin_amdgcn_sched_barrier(0);
        }
        return false;
    }
};

struct EpiMix {
    const Params* P;
    __device__ __forceinline__ bool operator()(Acc& acc, const Unit& u, int wr, int wc, int fr_, int fq_) const {
        int fr = fr_, fq = fq_; asm volatile("" : "+v"(fr), "+v"(fq));
        const int row0 = u.pm * BM + wr * 64 + fr, col0 = u.pn * BM + wc * 32 + 8 * fq;
        const bf16_t* proj = wsb(*P, PROJ_O);
        bf16_t* O = wsbw(*P, MIXIN_O);
        if (u.kind == 1) {
#pragma unroll
            for (int ai = 0; ai < 2; ++ai) {
                u32x4 gq[4][2];
#pragma unroll
                for (int m = 0; m < 4; ++m)
#pragma unroll
                    for (int bj = 0; bj < 2; ++bj) gq[m][bj] = *(const u32x4*)(proj + (size_t)(row0 + ai * HALF + m * 16) * INC + 3328 + col0 + bj * HALF);
#pragma unroll
                for (int m = 0; m < 4; ++m)
#pragma unroll
                    for (int bj = 0; bj < 2; ++bj) {
                        float gb[8], v[8];
                        unpack8(gq[m][bj], gb);
#pragma unroll
                        for (int i = 0; i < 8; ++i) v[i] = acc[ai][bj][m][i >> 2][i & 3] * sigm(gb[i]);
                        *(u32x4*)(O + (size_t)(row0 + ai * HALF + m * 16) * 1024 + col0 + bj * HALF) = pack8(v);
                    }
                __builtin_amdgcn_sched_barrier(0);
            }
            return false;
        }
#pragma unroll
        for (int am = 0; am < 4; ++am) {
            const int ai = am >> 1, m0 = (am & 1) * 2;
            u32x4 gbr[2][2], gar[2][2];
#pragma unroll
            for (int mm = 0; mm < 2; ++mm)
#pragma unroll
                for (int bj = 0; bj < 2; ++bj) {
                    const bf16_t* gp = proj + (size_t)(row0 + ai * HALF + (m0 + mm) * 16) * INC + 2304 + col0 + bj * HALF;
                    gbr[mm][bj] = *(const u32x4*)(gp + 1024);
                    if (u.kind == 0) gar[mm][bj] = *(const u32x4*)gp;
                }
#pragma unroll
            for (int mm = 0; mm < 2; ++mm) {
                const int m = m0 + mm, row = row0 + ai * HALF + m * 16;
#pragma unroll
                for (int bj = 0; bj < 2; ++bj) {
                    const int col = col0 + bj * HALF;
                    float gb[8];
                    unpack8(gbr[mm][bj], gb);
                    if (u.kind == 0) {
                        float ga[8];
                        unpack8(gar[mm][bj], ga);
#pragma unroll
                        for (int i = 0; i < 8; ++i) acc[ai][bj][m][i >> 2][i & 3] *= (1.f + __expf(-gb[i])) * rcp_(1.f + __expf(-ga[i]));
                    } else {
                        float v[8];
#pragma unroll
                        for (int i = 0; i < 8; ++i) v[i] = acc[ai][bj][m][i >> 2][i & 3] * sigm(gb[i]);
                        *(u32x4*)(O + (size_t)row * 1024 + col) = pack8(v);
                    }
                }
            }
            __builtin_amdgcn_sched_barrier(0);
        }
        return u.kind == 0;
    }
};

struct EpiUp {
    const Params* P;
    __device__ __forceinline__ bool operator()(Acc& acc, const Unit& u, int wr, int wc, int fr_, int fq_) const {
        int fr = fr_, fq = fq_; asm volatile("" : "+v"(fr), "+v"(fq));
        const int cg0 = u.pn * 128 + wc * 32 + 8 * fq;
        const float* cw = P->in[I_FCW]; const float* cbias = P->in[I_FCB];
        bf16_t* ACT = wsbw(*P, ACT_O);
        float* STASH = (float*)(P->ws + STASH_O);
#pragma unroll
        for (int n = 0; n < 2; ++n) {
            const int cg = cg0 + 4 * n;
            const f32x4 wg0 = *(const f32x4*)(cw + cg), wg1 = *(const f32x4*)(cw + DFF2 + cg), wg2 = *(const f32x4*)(cw + 2 * DFF2 + cg), bg = *(const f32x4*)(cbias + cg);
            const f32x4 wv0 = *(const f32x4*)(cw + DFF + cg), wv1 = *(const f32x4*)(cw + DFF2 + DFF + cg), wv2 = *(const f32x4*)(cw + 2 * DFF2 + DFF + cg), bv = *(const f32x4*)(cbias + DFF + cg);
            if (u.pm < 64) {
#pragma unroll
                for (int ai = 0; ai < 2; ++ai)
#pragma unroll
                    for (int m = 0; m < 4; ++m) {
                        const int rr = m * 16 + fr, row = u.pm * BM + ai * HALF + wr * 64 + rr;
                        const f32x4 g0 = acc[ai][0][m][n], v0 = acc[ai][1][m][n];
                        const f32x4 gp = acc[ai][0][m > 0 ? m - 1 : 0][n], vp = acc[ai][1][m > 0 ? m - 1 : 0][n];
                        float a[4], s1[8], s2[8];
#pragma unroll
                        for (int j = 0; j < 4; ++j) { s1[j] = fr == 15 ? gp[j] : g0[j]; s2[j] = fr >= 14 ? gp[j] : g0[j]; s1[4 + j] = fr == 15 ? vp[j] : v0[j]; s2[4 + j] = fr >= 14 ? vp[j] : v0[j]; }
                        __builtin_amdgcn_sched_barrier(0);
#pragma unroll
                        for (int j = 0; j < 8; ++j) { s1[j] = ror1(s1[j]); s2[j] = ror2(s2[j]); }
                        __builtin_amdgcn_sched_barrier(0);
#pragma unroll
                        for (int j = 0; j < 4; ++j) {
                            a[j] = gelu_t(fma_s(wg2[j], g0[j], fma_s(wg1[j], s1[j], fma_s(wg0[j], s2[j], bg[j]))));
                            a[j] *= fma_s(wv2[j], v0[j], fma_s(wv1[j], s1[4 + j], fma_s(wv0[j], s2[4 + j], bv[j])));
                        }
                        if (rr >= 2) {
                            u32x2 w; w.x = pk2(a[0], a[1]); w.y = pk2(a[2], a[3]);
                            *(u32x2*)(ACT + (size_t)row * DFF + cg) = w;
                        }
                        if (rr < 2 || rr >= 62) {
                            float* sp = STASH + ((size_t)(row >> 6) * 4 + (rr < 2 ? rr : rr - 60)) * DFF2;
                            *(f32x4*)(sp + cg) = g0; *(f32x4*)(sp + DFF + cg) = v0;
                        }
                        __builtin_amdgcn_sched_barrier(0);
                    }
            } else {
                float* SUP = (float*)(P->ws + SUP_O);
#pragma unroll
                for (int m = 0; m < 4; ++m) {
                    const int b = wr * 64 + m * 16 + fr;
                    *(f32x4*)(SUP + (size_t)b * DFF2 + cg) = acc[0][0][m][n]; *(f32x4*)(SUP + (size_t)b * DFF2 + DFF + cg) = acc[0][1][m][n];
                }
            }
        }
        return false;
    }
};

__device__ void phase0(const Params& P, LAS unsigned char* ldsb, int bid, int nb) {
    LAS float* tile = (LAS float*)ldsb;
    const int tid = TID(), wid = tid >> 6, lane = tid & 63;
    const int nt_in = 16 * 68, nt_a = 8 * 16, nt_b = 8 * 16, nt_o = 16 * 16, nt_up = 16 * 88, nt_dn = 44 * 16;
    const int total = (nb == 256) ? nt_in : nt_in + nt_a + nt_b + nt_o + nt_up + nt_dn;
    auto tile_info = [&](int j, const float*& src, bf16_t*& dst, int& K, int& N, int& k0, int& n0, int& drow0) {
        int jj = j, mode = 0;
        if (jj < nt_in) { src = P.in[I_WIN]; dst = wsbw(P, W_IN_T); K = 1024; N = 4352; }
        else if ((jj -= nt_in) < nt_a) { src = P.in[I_WOUT]; dst = wsbw(P, W_A_T); K = 512; N = 1024; }
        else if ((jj -= nt_a) < nt_b) { src = P.in[I_LWOUT]; dst = wsbw(P, W_B_T); K = 512; N = 1024; }
        else if ((jj -= nt_b) < nt_o) { src = P.in[I_WO]; dst = wsbw(P, W_O_T); K = 1024; N = 1024; }
        else if ((jj -= nt_o) < nt_up) { src = P.in[I_FUP]; dst = wsbw(P, W_UP_T); K = 1024; N = 5632; mode = 1; }
        else { jj -= nt_up; src = P.in[I_FDN]; dst = wsbw(P, W_DN_T); K = 2816; N = 1024; }
        const int ntn = N / 64; k0 = (jj / ntn) * 64; n0 = (jj % ntn) * 64;
        drow0 = n0;
        if (mode == 1) { if (n0 < DFF) drow0 = (n0 / 128) * 256 + (n0 % 128); else { const int q = n0 - DFF; drow0 = (q / 128) * 256 + 128 + (q % 128); } }
    };
    {
        f32x4 rv[2];
        const float* src; bf16_t* dst; int K, N, k0, n0, drow0;
        int j = bid;
        if (j < total) { tile_info(j, src, dst, K, N, k0, n0, drow0);
#pragma unroll
            for (int i = 0; i < 2; ++i) { const int idx = tid + 512 * i, kk = idx >> 4, n4 = (idx & 15) * 4; rv[i] = __builtin_nontemporal_load((const f32x4*)(src + (size_t)(k0 + kk) * N + n0 + n4)); } }
        while (j < total) {
#pragma unroll
            for (int i = 0; i < 2; ++i) { const int idx = tid + 512 * i, kk = idx >> 4, n4 = (idx & 15) * 4;
                tile[kk * 65 + n4] = rv[i].x; tile[kk * 65 + n4 + 1] = rv[i].y; tile[kk * 65 + n4 + 2] = rv[i].z; tile[kk * 65 + n4 + 3] = rv[i].w; }
            bf16_t* cdst = dst; const int cK = K, ck0 = k0, cdrow0 = drow0;
            j += nb;
            if (j < total) { tile_info(j, src, dst, K, N, k0, n0, drow0);
#pragma unroll
                for (int i = 0; i < 2; ++i) { const int idx = tid + 512 * i, kk = idx >> 4, n4 = (idx & 15) * 4; rv[i] = __builtin_nontemporal_load((const f32x4*)(src + (size_t)(k0 + kk) * N + n0 + n4)); } }
            asm volatile("s_waitcnt lgkmcnt(0)\n\ts_barrier" ::: "memory");
#pragma unroll
            for (int i = 0; i < 4; ++i) { const int idx = tid + 512 * i, nn = idx >> 5, kp = idx & 31;
                *(unsigned*)(cdst + (size_t)(cdrow0 + nn) * cK + ck0 + 2 * kp) = pk2(tile[(2 * kp) * 65 + nn], tile[(2 * kp + 1) * 65 + nn]); }
            asm volatile("s_waitcnt lgkmcnt(0)\n\ts_barrier" ::: "memory");
        }
    }
    const int gtid = bid * 512 + tid, gth = nb * 512;
    { bf16_t* W = wsbw(P, W_LORA_T);
      for (int idx = gtid; idx < 256 * 512; idx += gth) { const int k = idx >> 9, n = idx & 511;
          const float v = k < 64 ? P.in[I_WUP][k * 512 + n] : (k < 128 ? P.in[I_AUP][(k - 64) * 512 + n] : P.in[I_GUP][(k - 128) * 512 + n]);
          const int sec = k < 64 ? 0 : (k < 128 ? 1 : 2);
#pragma unroll
          for (int t = 0; t < 3; ++t) W[(size_t)(t * 512 + n) * 256 + k] = (t == sec) ? f2bf(v) : (bf16_t)0; } }
    { bf16_t* W = wsbw(P, W_LRUG_T);
      for (int idx = gtid; idx < 512 * 1024; idx += gth) { const int k = idx >> 10, n = idx & 1023; const int pn = n >> 8, wi = n & 255, ch = pn * 128 + (wi & 127), blk = ch >> 6, jc = ch & 63;
          float v = 0.f; if ((k >> 6) == blk) v = (wi >= 128 ? P.in[I_GAW] : P.in[I_GXW])[blk * 4096 + (k & 63) * 64 + jc];
          W[(size_t)n * 512 + k] = f2bf(v); } }
    { float* r1 = (float*)(P.ws + ROWSS1); float* r2 = (float*)(P.ws + ROWSS2);
      for (int idx = gtid; idx < MPAD; idx += gth) { r1[idx] = 0.f; r2[idx] = 0.f; } }
    bf16_t* XN = wsbw(P, XN_O);
    for (int rowA = bid * 8 + wid; rowA < MP; rowA += nb * 16) {
        const int rowB = rowA + nb * 8; const bool hasB = rowB < MP; const int rows[2] = {rowA, hasB ? rowB : rowA};
        f32x4 v[2][4]; float ss[2] = {0.f, 0.f};
#pragma unroll
        for (int q = 0; q < 2; ++q)
#pragma unroll
            for (int i = 0; i < 4; ++i) v[q][i] = __builtin_nontemporal_load((const f32x4*)(P.in[I_XP] + (size_t)rows[q] * 1024 + lane * 4 + 256 * i));
#pragma unroll
        for (int q = 0; q < 2; ++q)
#pragma unroll
            for (int i = 0; i < 4; ++i) ss[q] += v[q][i].x * v[q][i].x + v[q][i].y * v[q][i].y + v[q][i].z * v[q][i].z + v[q][i].w * v[q][i].w;
        ss[0] = wave_sum(ss[0]); ss[1] = wave_sum(ss[1]);
#pragma unroll
        for (int q = 0; q < 2; ++q) { const float sc = rsqrtf(ss[q] * (1.f / 1024.f) + 1e-6f);
            if (q == 0 || hasB) {
#pragma unroll
                for (int i = 0; i < 4; ++i) { const f32x4 g = *(const f32x4*)(P.in[I_NPM] + lane * 4 + 256 * i); const f32x4 t = v[q][i] * sc * g;
                    u32x2 w; w.x = pk2(t.x, t.y); w.y = pk2(t.z, t.w); *(u32x2*)(XN + (size_t)rows[q] * 1024 + lane * 4 + 256 * i) = w; } } }
    }
    for (int row = MP + bid * 8 + wid; row < MPAD; row += nb * 8) {
        bf16_t* o = XN + (size_t)row * 1024;
        if (row >= MT) { for (int i = 0; i < 4; ++i) *(u32x2*)(o + lane * 4 + 256 * i) = (u32x2){0u, 0u}; continue; }
        const float* x = row < MP ? P.in[I_XP] + (size_t)row * 1024 : P.in[I_XS] + (size_t)(row - MP) * 1024;
        f32x4 v[4]; float ss = 0.f;
#pragma unroll
        for (int i = 0; i < 4; ++i) { v[i] = *(const f32x4*)(x + lane * 4 + 256 * i); ss += v[i].x * v[i].x + v[i].y * v[i].y + v[i].z * v[i].z + v[i].w * v[i].w; }
        ss = wave_sum(ss);
        const float sc = rsqrtf(ss * (1.f / 1024.f) + 1e-6f);
#pragma unroll
        for (int i = 0; i < 4; ++i) { const f32x4 g = *(const f32x4*)(P.in[I_NPM] + lane * 4 + 256 * i);
            u32x2 w; w.x = pk2(v[i].x * sc * g.x, v[i].y * sc * g.y); w.y = pk2(v[i].z * sc * g.z, v[i].w * sc * g.w); *(u32x2*)(o + lane * 4 + 256 * i) = w; }
    }
}

__device__ void phase_b0(const Params& P, int bid, int nb) {
    const int tid = TID(), wid = tid >> 6, lane = tid & 63;
    const bf16_t* proj = wsb(P, PROJ_O);
    bf16_t* LA = outb(P, LA_O); bf16_t* XC = outb(P, XC_O); bf16_t* KK = wsbw(P, KK_O);
    for (int row = bid * 8 + wid; row < MPAD; row += nb * 8) {
        if (row >= MT) {
            const u32x4 z = (u32x4){0u, 0u, 0u, 0u};
            if (lane < 32) *(u32x4*)(LA + (size_t)row * 256 + 8 * lane) = z;
            *(u32x4*)(XC + (size_t)row * 512 + 8 * lane) = z; *(u32x4*)(KK + (size_t)row * 512 + 8 * lane) = z;
            continue;
        }
        const bool sample = row >= MP; const int b = sample ? row - MP : row >> 11, t = sample ? 0 : (row & 2047);
        float m[8];
        { shifted8(P, row, 512 + 8 * lane, m);
          float kk[8], kkw[8]; ld8f(P.in[I_KK] + 8 * lane, kkw); float ss = 0.f;
#pragma unroll
          for (int i = 0; i < 8; ++i) { kk[i] = m[i] * kkw[i]; ss += kk[i] * kk[i]; }
          ss += __shfl_xor(ss, 1); ss += __shfl_xor(ss, 2); ss += __shfl_xor(ss, 4);
          const float inv = 1.f / fmaxf(sqrtf(ss), 1e-12f);
#pragma unroll
          for (int i = 0; i < 8; ++i) kk[i] *= inv;
          *(u32x4*)(KK + (size_t)row * 512 + 8 * lane) = pack8(kk); }
        if (lane < 32) {
            shifted8(P, row, 1536 + 8 * lane, m);
            if (lane < 8) { for (int i = 0; i < 8; ++i) m[i] = tanh_(m[i]); }
            else if (lane >= 16) { for (int i = 0; i < 8; ++i) m[i] = sigm(m[i]); }
            *(u32x4*)(LA + (size_t)row * 256 + 8 * lane) = pack8(m);
        }
        { const int c0 = 8 * lane; float x0[8], x1[8], x2[8], x3[8];
          ld8bf(proj + (size_t)row * INC + RP + c0, x3);
          if (sample) { const float* sb = P.in[I_SLCONV] + (size_t)b * 3 * 512 + c0; ld8f(sb, x0); ld8f(sb + 512, x1); ld8f(sb + 1024, x2); }
          else {
              if (t >= 1) ld8bf(proj + (size_t)(row - 1) * INC + RP + c0, x2); else { for (int i = 0; i < 8; ++i) x2[i] = 0.f; }
              if (t >= 2) ld8bf(proj + (size_t)(row - 2) * INC + RP + c0, x1); else { for (int i = 0; i < 8; ++i) x1[i] = 0.f; }
              if (t >= 3) ld8bf(proj + (size_t)(row - 3) * INC + RP + c0, x0); else { for (int i = 0; i < 8; ++i) x0[i] = 0.f; }
          }
          float w0[8], w1[8], w2[8], w3[8], cb[8], xc[8];
          ld8f(P.in[I_LCW] + c0, w0); ld8f(P.in[I_LCW] + 512 + c0, w1); ld8f(P.in[I_LCW] + 1024 + c0, w2); ld8f(P.in[I_LCW] + 1536 + c0, w3); ld8f(P.in[I_LCB] + c0, cb);
#pragma unroll
          for (int i = 0; i < 8; ++i) xc[i] = cb[i] + w0[i] * x0[i] + w1[i] * x1[i] + w2[i] * x2[i] + w3[i] * x3[i];
          *(u32x4*)(XC + (size_t)row * 512 + c0) = pack8(xc);
          if (sample) { float* o = P.out + O_SLCONV + (size_t)b * 3 * 512 + c0; st8f(o, x1); st8f(o + 512, x2); st8f(o + 1024, x3); }
          else if (t == 2047) { float* o = P.out + O_PLCONV + (size_t)b * 3 * 512 + c0; st8f(o, x1); st8f(o + 512, x2); st8f(o + 1024, x3); }
        }
        if (sample || t == 2047) {
            float* o = P.out + (sample ? O_SSHIFT : O_PSHIFT) + (size_t)b * RP;
            for (int ci = lane; ci < 224; ci += 64) { float p[8]; ld8bf(proj + (size_t)row * INC + 8 * ci, p); st8f(o + 8 * ci, p); }
        }
    }
}

__device__ __forceinline__ void sample_wkv(const Params& P, int w0, int nw) {
    const int lane = TID() & 63, rowq = lane >> 4, kq = lane & 15;
    const bf16_t* proj = wsb(P, PROJ_O);
    const bf16_t* E = wsb(P, E_O); const bf16_t* AS = wsb(P, ASIG_O); const bf16_t* KK = wsb(P, KK_O);
    bf16_t* Y = wsbw(P, Y_O);
    for (int it = w0; it < 128 * 8; it += nw) {
        const int b = it >> 3, h = it & 7, row = MP + b, hc = h * 64 + 4 * kq, vc = 1024 + h * 64 + lane;
        const bf16_t* pr = proj + (size_t)row * INC; const float* sh = P.in[I_SSHIFT] + (size_t)b * RP; const float* mu = P.in[I_MU];
        const float* S0 = P.in[I_SWKV] + (size_t)(b * 8 + h) * 4096;
        float* S1 = P.out + O_SWKV + (size_t)(b * 8 + h) * 4096;
        f32x4 st[8];
#pragma unroll
        for (int i = 0; i < 8; ++i) st[i] = __builtin_nontemporal_load((const f32x4*)(S0 + (4 * i + rowq) * 64 + 4 * kq));
        const u32x2 pr_r = *(const u32x2*)(pr + hc), pr_k = *(const u32x2*)(pr + 512 + hc);
        const f32x4 sh_r = *(const f32x4*)(sh + hc), sh_k = *(const f32x4*)(sh + 512 + hc), mu_r = *(const f32x4*)(mu + hc), mu_k = *(const f32x4*)(mu + 512 + hc);
        const f32x4 ka = *(const f32x4*)(P.in[I_KA] + hc);
        const u32x2 a4 = *(const u32x2*)(AS + (size_t)row * 512 + hc), kk4 = *(const u32x2*)(KK + (size_t)row * 512 + hc), e4 = *(const u32x2*)(E + (size_t)row * 512 + hc);
        const float pvv = bf1(pr[vc]), shv = sh[vc], muv = mu[vc];
        const float mv = pvv + muv * (shv - pvv);
        const float pr_[4] = {bflo(pr_r.x), bfhi(pr_r.x), bflo(pr_r.y), bfhi(pr_r.y)}, pk_[4] = {bflo(pr_k.x), bfhi(pr_k.x), bflo(pr_k.y), bfhi(pr_k.y)};
        const float a_[4] = {bflo(a4.x), bfhi(a4.x), bflo(a4.y), bfhi(a4.y)}, kk_[4] = {bflo(kk4.x), bfhi(kk4.x), bflo(kk4.y), bfhi(kk4.y)}, e_[4] = {bflo(e4.x), bfhi(e4.x), bflo(e4.y), bfhi(e4.y)};
        float d[4], kp[4], na[4], nbv[4], r[4];
#pragma unroll
        for (int i = 0; i < 4; ++i) {
            r[i] = pr_[i] + mu_r[i] * (sh_r[i] - pr_[i]);
            const float mk = pk_[i] + mu_k[i] * (sh_k[i] - pk_[i]);
            d[i] = __expf(-e_[i]); kp[i] = mk * (1.f + (a_[i] - 1.f) * ka[i]); na[i] = -kk_[i]; nbv[i] = kk_[i] * a_[i];
        }
        { const f32x4 rk4 = *(const f32x4*)(P.in[I_RK] + hc);
          float bo = r[0] * kp[0] * rk4[0] + r[1] * kp[1] * rk4[1] + r[2] * kp[2] * rk4[2] + r[3] * kp[3] * rk4[3];
          bo = row16_sum(bo);
          if (lane == 0) ((float*)(P.ws + BON_O))[(size_t)row * 8 + h] = bo; }
#pragma unroll
        for (int i = 0; i < 16; ++i) {
            const int v = 4 * i + rowq;
            if (i == 8) {
#pragma unroll
                for (int i2 = 0; i2 < 8; ++i2) st[i2] = __builtin_nontemporal_load((const f32x4*)(S0 + (4 * (8 + i2) + rowq) * 64 + 4 * kq));
            }
            f32x4 s = st[i & 7];
            const float vv = __shfl(mv, v);
            float sa = s.x * na[0] + s.y * na[1] + s.z * na[2] + s.w * na[3];
            sa = row16_sum(sa);
            s.x = s.x * d[0] + sa * nbv[0] + vv * kp[0]; s.y = s.y * d[1] + sa * nbv[1] + vv * kp[1];
            s.z = s.z * d[2] + sa * nbv[2] + vv * kp[2]; s.w = s.w * d[3] + sa * nbv[3] + vv * kp[3];
            float y = s.x * r[0] + s.y * r[1] + s.z * r[2] + s.w * r[3];
            y = row16_sum(y);
            *(f32x4*)(S1 + v * 64 + 4 * kq) = s;
            if (kq == 0) Y[(size_t)row * 512 + h * 64 + v] = f2bf(y);
        }
    }
}

typedef float f32x2 __attribute__((ext_vector_type(2)));
__device__ __forceinline__ void lru_pass1(const Params& P, int t0, int nt) {
    const bf16_t* LLA = outb(P, LLA_O); const bf16_t* LU = outb(P, LU_O);
    f32x2* CP = (f32x2*)(P.ws + CARRY_P); f32x2* CH = (f32x2*)(P.ws + CARRY_H);
    for (int idx = t0; idx < 8 * 64 * 256; idx += nt) {
        const int c2 = idx & 255, chunk = (idx >> 8) & 63, b = idx >> 14;
        const size_t base = ((size_t)b * 2048 + chunk * 32) * 512 + 2 * c2;
        float h0 = 0.f, h1 = 0.f, s0 = 0.f, s1 = 0.f;
#pragma unroll 1
        for (int hb = 0; hb < 2; ++hb) {
            unsigned la[16], uu[16];
#pragma unroll
            for (int t = 0; t < 16; ++t) { la[t] = __builtin_nontemporal_load((const unsigned*)(LLA + base + (size_t)(hb * 16 + t) * 512)); uu[t] = __builtin_nontemporal_load((const unsigned*)(LU + base + (size_t)(hb * 16 + t) * 512)); }
#pragma unroll
            for (int t = 0; t < 16; ++t) { const float a0 = bflo(la[t]), a1 = bfhi(la[t]); h0 = __expf(a0) * h0 + bflo(uu[t]); h1 = __expf(a1) * h1 + bfhi(uu[t]); s0 += a0; s1 += a1; }
        }
        CP[idx] = (f32x2){s0, s1}; CH[idx] = (f32x2){h0, h1};
    }
}
__device__ __forceinline__ void sample_lru(const Params& P, int t0, int nt) {
    const bf16_t* LLA = outb(P, LLA_O); bf16_t* LU = outb(P, LU_O);
    for (int idx = t0; idx < 256 * 512; idx += nt) {
        const int c = idx & 511, b = idx >> 9; const size_t o = (size_t)(MP + b) * 512 + c;
        if (b < 128) { const float h = __expf(bf1(LLA[o])) * P.in[I_SLH][b * 512 + c] + bf1(LU[o]); P.out[O_SLH + b * 512 + c] = h; LU[o] = f2bf(h); }
        else LU[o] = 0;
    }
}
__device__ void lru_pass2(const Params& P, int bid, int nb) {
    const bf16_t* LLA = outb(P, LLA_O); bf16_t* LU = outb(P, LU_O);
    const f32x2* CP = (const f32x2*)(P.ws + CARRY_P); const f32x2* CH = (const f32x2*)(P.ws + CARRY_H);
    for (int idx = bid * 512 + TID(); idx < 8 * 64 * 256; idx += nb * 512) {
        const int c2 = idx & 255, chunk = (idx >> 8) & 63, b = idx >> 14;
        const size_t base = ((size_t)b * 2048 + chunk * 32) * 512 + 2 * c2;
        unsigned la[32], uu[32];
#pragma unroll
        for (int t = 0; t < 32; ++t) { la[t] = __builtin_nontemporal_load((const unsigned*)(LLA + base + (size_t)t * 512)); uu[t] = __builtin_nontemporal_load((const unsigned*)(LU + base + (size_t)t * 512)); }
        float h0 = 0.f, h1 = 0.f;
        for (int j0 = 0; j0 < chunk; j0 += 16) {
            f32x2 cp[16], ch[16];
#pragma unroll
            for (int i = 0; i < 16; ++i) { const int j = (j0 + i < chunk) ? j0 + i : chunk - 1; const int k = ((b * 64 + j) << 8) + c2; cp[i] = CP[k]; ch[i] = CH[k]; }
#pragma unroll
            for (int i = 0; i < 16; ++i) if (j0 + i < chunk) { h0 = __expf(cp[i].x) * h0 + ch[i].x; h1 = __expf(cp[i].y) * h1 + ch[i].y; }
        }
#pragma unroll
        for (int t = 0; t < 32; ++t) { h0 = __expf(bflo(la[t])) * h0 + bflo(uu[t]); h1 = __expf(bfhi(la[t])) * h1 + bfhi(uu[t]); *(unsigned*)(LU + base + (size_t)t * 512) = pk2(h0, h1); }
        if (chunk == 63) *(f32x2*)(P.out + O_PLH + b * 512 + 2 * c2) = (f32x2){h0, h1};
    }
}

constexpr int WT_A = 64 * 16, WT_B = 64 * 16, WT_O = 128 * 16, WT_UP = 128 * 88, WT_DN = 352 * 16, WT_TOTAL = WT_A + WT_B + WT_O + WT_UP + WT_DN;
__device__ __forceinline__ void wt_task(const Params& P, int task, int lane, const float*& src, int& N, bf16_t*& dstp) {
    int j = task, K, mode = 0; bf16_t* dst;
    if (j < WT_A) { src = P.in[I_WOUT]; dst = wsbw(P, W_A_T); K = 512; N = 1024; }
    else if ((j -= WT_A) < WT_B) { src = P.in[I_LWOUT]; dst = wsbw(P, W_B_T); K = 512; N = 1024; }
    else if ((j -= WT_B) < WT_O) { src = P.in[I_WO]; dst = wsbw(P, W_O_T); K = 1024; N = 1024; }
    else if ((j -= WT_O) < WT_UP) { src = P.in[I_FUP]; dst = wsbw(P, W_UP_T); K = 1024; N = 5632; mode = 1; }
    else { j -= WT_UP; src = P.in[I_FDN]; dst = wsbw(P, W_DN_T); K = 2816; N = 1024; }
    const int ntn = N / 64, k0 = (j / ntn) * 8, n = (j % ntn) * 64 + lane;
    int drow = n;
    if (mode == 1) { if (n < DFF) drow = (n / 128) * 256 + (n % 128); else { const int q = n - DFF; drow = (q / 128) * 256 + 128 + (q % 128); } }
    src += (size_t)k0 * N + n; dstp = dst + (size_t)drow * K + k0;
}

constexpr int CHS = 32, REC = 388, NCH = 2048 / CHS;
#define SC_BAR() asm volatile("s_waitcnt lgkmcnt(0)\n\ts_barrier" ::: "memory")
template <bool EXTRAS>
__device__ void wkv_scan(const Params& P, int it, LAS float* lds, int bid, int nb) {
    const int tid = TID(), wid = __builtin_amdgcn_readfirstlane(tid >> 6), lane = tid & 63;
    const int xcd = it & 7, jj = it >> 3, s = jj & 3, bh = xcd + 8 * (jj >> 2), b = bh >> 3, h = bh & 7;
    LAS float* buf0 = lds; LAS float* buf1 = lds + CHS * REC; LAS float* yb = lds + 2 * CHS * REC;
    const size_t rowbase = (size_t)b * 2048;
    if (wid >= 4) {
        const int p = tid - 256, st = p >> 3, c8 = (p & 7) * 8, hc = h * 64 + c8;
        const bf16_t* proj = wsb(P, PROJ_O); const bf16_t* E = wsb(P, E_O); const bf16_t* AS = wsb(P, ASIG_O); const bf16_t* KK = wsb(P, KK_O);
        bf16_t* Y_ = wsbw(P, Y_O);
        float mur[8], muk[8], muv[8], ka[8];
        ld8f(P.in[I_MU] + hc, mur); ld8f(P.in[I_MU] + 512 + hc, muk); ld8f(P.in[I_MU] + 1024 + hc, muv); ld8f(P.in[I_KA] + hc, ka);
        struct Raw { u32x4 r, k, v, rp, kp, vp, e, a, kk; };
        Raw X, Y;
#define SC_LOAD(L, chunk) do { const int t_ = (chunk) * CHS + st; const size_t row_ = rowbase + t_; const bf16_t* pr_ = proj + row_ * INC + hc; \
        L.r = *(const u32x4*)pr_; L.k = *(const u32x4*)(pr_ + 512); L.v = *(const u32x4*)(pr_ + 1024); \
        if (t_ > 0) { L.rp = *(const u32x4*)(pr_ - INC); L.kp = *(const u32x4*)(pr_ - INC + 512); L.vp = *(const u32x4*)(pr_ - INC + 1024); } \
        else { L.rp = (u32x4){0u, 0u, 0u, 0u}; L.kp = L.rp; L.vp = L.rp; } \
        L.e = *(const u32x4*)(E + row_ * 512 + hc); L.a = *(const u32x4*)(AS + row_ * 512 + hc); L.kk = *(const u32x4*)(KK + row_ * 512 + hc); } while (0)
#define SC_WRITE(L, buf, chunk) do { LAS float* rec_ = (buf) + st * REC + c8; float r_[8], rp_[8], k_[8], kpv_[8], v_[8], vp_[8], e_[8], a_[8], kk_[8]; \
        unpack8(L.r, r_); unpack8(L.rp, rp_); unpack8(L.k, k_); unpack8(L.kp, kpv_); unpack8(L.v, v_); unpack8(L.vp, vp_); unpack8(L.e, e_); unpack8(L.a, a_); unpack8(L.kk, kk_); \
        float od_[8], ok_[8], ona_[8], onb_[8], or_[8], ov_[8]; \
        _Pragma("unroll") for (int i = 0; i < 8; ++i) { or_[i] = r_[i] + mur[i] * (rp_[i] - r_[i]); const float mk_ = k_[i] + muk[i] * (kpv_[i] - k_[i]); ov_[i] = v_[i] + muv[i] * (vp_[i] - v_[i]); \
            od_[i] = __expf(-e_[i]); ok_[i] = mk_ * (1.f + (a_[i] - 1.f) * ka[i]); ona_[i] = -kk_[i]; onb_[i] = kk_[i] * a_[i]; } \
        LAS float* nd_ = (buf) + st * REC + c8; \
        *(LAS f32x4*)(nd_) = (f32x4){ona_[0], od_[0] * or_[0], ona_[1], od_[1] * or_[1]}; *(LAS f32x4*)(nd_ + 64) = (f32x4){ona_[2], od_[2] * or_[2], ona_[3], od_[3] * or_[3]}; \
        *(LAS f32x4*)(nd_ + 4) = (f32x4){ona_[4], od_[4] * or_[4], ona_[5], od_[5] * or_[5]}; *(LAS f32x4*)(nd_ + 68) = (f32x4){ona_[6], od_[6] * or_[6], ona_[7], od_[7] * or_[7]}; \
        *(LAS f32x4*)(rec_ + 128) = (f32x4){od_[0], od_[1], od_[2], od_[3]}; *(LAS f32x4*)(rec_ + 132) = (f32x4){od_[4], od_[5], od_[6], od_[7]}; \
        *(LAS f32x4*)(rec_ + 192) = (f32x4){ok_[0], ok_[1], ok_[2], ok_[3]}; *(LAS f32x4*)(rec_ + 196) = (f32x4){ok_[4], ok_[5], ok_[6], ok_[7]}; \
        *(LAS f32x4*)(rec_ + 256) = (f32x4){onb_[0], onb_[1], onb_[2], onb_[3]}; *(LAS f32x4*)(rec_ + 260) = (f32x4){onb_[4], onb_[5], onb_[6], onb_[7]}; \
        { float c1_ = 0.f, c2_ = 0.f, bo_ = 0.f; float rkc_[8]; ld8f(P.in[I_RK] + hc, rkc_);     \
          _Pragma("unroll") for (int i = 0; i < 8; ++i) { c1_ += onb_[i] * or_[i]; c2_ += ok_[i] * or_[i]; bo_ += ok_[i] * or_[i] * rkc_[i]; } \
          c1_ += __shfl_xor(c1_, 1); c2_ += __shfl_xor(c2_, 1); bo_ += __shfl_xor(bo_, 1); c1_ += __shfl_xor(c1_, 2); c2_ += __shfl_xor(c2_, 2); bo_ += __shfl_xor(bo_, 2); \
          c1_ += __shfl_xor(c1_, 4); c2_ += __shfl_xor(c2_, 4); bo_ += __shfl_xor(bo_, 4); \
          if (s == 0 && (p & 7) == 0) ((float*)(P.ws + BON_O))[(rowbase + (chunk) * CHS + st) * 8 + h] = bo_; \
          LAS float* rs_ = (buf) + st * REC + 320 + 8 * (p & 7); *(LAS f32x2*)(rs_) = (f32x2){c1_, c2_}; *(LAS f32x2*)(rs_ + 4) = (f32x2){c1_, c2_}; } \
        if ((c8 >> 4) == s) { LAS float* vr_ = (buf) + st * REC + 320 + 4 * (c8 & 15) + 2; _Pragma("unroll") for (int i = 0; i < 8; ++i) vr_[4 * i] = ov_[i]; } } while (0)
#define SC_FLUSH(chunk) do { const LAS float* yy_ = yb + ((chunk) & 1) * CHS * 16 + st * 16 + 2 * (p & 7); \
        *(unsigned*)(Y_ + (rowbase + (chunk) * CHS + st) * 512 + h * 64 + 16 * s + 2 * (p & 7)) = pk2(yy_[0], yy_[1]); } while (0)
        SC_LOAD(X, 0); SC_LOAD(Y, 1); SC_WRITE(X, buf0, 0); SC_LOAD(X, 2);
        SC_BAR();
        for (int c = 0; c < NCH; c += 2) {
            if (c + 1 < NCH) SC_WRITE(Y, buf1, c + 1);
            if (c + 3 < NCH) SC_LOAD(Y, c + 3);
            if (c > 0) SC_FLUSH(c - 1);
            float wtv[8]; bf16_t* wtd = nullptr;
            if (EXTRAS) {
                int pp = p; asm volatile("" : "+v"(pp));
                if (c == 46) lru_pass1(P, bid * 256 + pp, nb * 256);
                else if (c == 50) sample_lru(P, bid * 256 + pp, nb * 256);
                else if (c == 54) sample_wkv(P, bid * 4 + (pp >> 6), nb * 4);
                const int task = (c < 44) ? bid * 4 + (pp >> 6) + nb * 4 * (c >> 1) : WT_TOTAL;
                if (task < WT_TOTAL) { const float* src; int N;
                    wt_task(P, task, pp & 63, src, N, wtd);
#pragma unroll
                    for (int i = 0; i < 8; ++i) wtv[i] = __builtin_nontemporal_load(src + (size_t)i * N); }
            }
            SC_BAR();
            if (EXTRAS && wtd) { u32x4 w0; w0.x = pk2(wtv[0], wtv[1]); w0.y = pk2(wtv[2], wtv[3]); w0.z = pk2(wtv[4], wtv[5]); w0.w = pk2(wtv[6], wtv[7]); *(u32x4*)wtd = w0; }
            if (c + 2 < NCH) SC_WRITE(X, buf0, c + 2);
            if (c + 4 < NCH) SC_LOAD(X, c + 4);
            SC_FLUSH(c);
            SC_BAR();
        }
        SC_FLUSH(NCH - 1);
#undef SC_LOAD
#undef SC_WRITE
#undef SC_FLUSH
    } else {
        const int rowq = lane >> 4, kq = lane & 15, rloc = 4 * wid + rowq;
        f32x4 S = (f32x4){0.f, 0.f, 0.f, 0.f};
        struct Ops { f32x4 nd0, nd1, d, kp, nb, rs; };
#define SC_LD(X, st_) do { X.nd0 = *(const LAS f32x4*)(bk4 + (st_) * REC - 128); X.nd1 = *(const LAS f32x4*)(bk4 + (st_) * REC - 64); \
        X.d = *(const LAS f32x4*)(bk4 + (st_) * REC); X.kp = *(const LAS f32x4*)(bk4 + (st_) * REC + 64); X.nb = *(const LAS f32x4*)(bk4 + (st_) * REC + 128); \
        X.rs = *(const LAS f32x4*)(br + (st_) * REC); } while (0)
#define SC_STEP(X, j_) do { f32x2 p_ = (f32x2){S.x, S.x} * (f32x2){X.nd0.x, X.nd0.y}; p_ = (f32x2){S.y, S.y} * (f32x2){X.nd0.z, X.nd0.w} + p_; \
        p_ = (f32x2){S.z, S.z} * (f32x2){X.nd1.x, X.nd1.y} + p_; p_ = (f32x2){S.w, S.w} * (f32x2){X.nd1.z, X.nd1.w} + p_; \
        const f32x4 T_ = S * X.d + X.rs.z * X.kp; \
        float sa_ = p_.x, q_ = p_.y; \
        sa_ += dppf<0xB1>(sa_); q_ += dppf<0xB1>(q_); sa_ += dppf<0x4E>(sa_); q_ += dppf<0x4E>(q_); sa_ += dppf<0x141>(sa_); q_ += dppf<0x141>(q_); sa_ += dppf<0x140>(sa_); q_ += dppf<0x140>(q_); \
        S = T_ + sa_ * X.nb; \
        const float y_ = q_ + sa_ * X.rs.x + X.rs.z * X.rs.y; yacc = (kq == (j_)) ? y_ : yacc; } while (0)
        SC_BAR();
        for (int c = 0; c < NCH; ++c) {
            const LAS float* bufc = (c & 1) ? buf1 : buf0; LAS float* ybc = yb + (c & 1) * CHS * 16;
            const LAS float* bk4 = bufc + 128 + 4 * kq; const LAS float* br = bufc + 320 + 4 * rloc;
            Ops A, B;
            SC_LD(A, 0);
#pragma unroll
            for (int g = 0; g < 2; ++g) {
                float yacc = 0.f;
#pragma unroll
                for (int j = 0; j < 16; j += 2) {
                    SC_LD(B, g * 16 + j + 1);
                    SC_STEP(A, j);
                    __builtin_amdgcn_sched_barrier(0);
                    if (g * 16 + j + 2 < CHS) SC_LD(A, g * 16 + j + 2);
                    SC_STEP(B, j + 1);
                    __builtin_amdgcn_sched_barrier(0);
                }
                ybc[(g * 16 + kq) * 16 + rloc] = yacc;
            }
            SC_BAR();
        }
#undef SC_LD
#undef SC_STEP
        *(f32x4*)(P.out + O_PWKV + ((size_t)(b * 8 + h) * 64 + 16 * s + rloc) * 64 + 4 * kq) = S;
    }
}

__device__ void phase_za(const Params& P, int bid, int nb) {
    const int tid = TID(), wid = tid >> 6, lane = tid & 63, c0 = 8 * lane;
    const bf16_t* G = wsb(P, G_O); const bf16_t* Y = wsb(P, Y_O);
    bf16_t* ZA = outb(P, ZA_O);
    for (int row = bid * 8 + wid; row < MPAD; row += nb * 8) {
        if (row >= MT) { *(u32x4*)(ZA + (size_t)row * 512 + c0) = (u32x4){0u, 0u, 0u, 0u}; continue; }
        float v[8], y[8], g[8], lw[8], lb[8], za[8];
        shifted8(P, row, 1024 + c0, v);
        ld8bf_nt(Y + (size_t)row * 512 + c0, y); ld8bf_nt(G + (size_t)row * 512 + c0, g);
        ld8f(P.in[I_LNW] + c0, lw); ld8f(P.in[I_LNB] + c0, lb);
        const float sb = ((const float*)(P.ws + BON_O))[(size_t)row * 8 + (lane >> 3)];
        float sy = 0.f;
#pragma unroll
        for (int i = 0; i < 8; ++i) sy += y[i];
        sy += __shfl_xor(sy, 1); sy += __shfl_xor(sy, 2); sy += __shfl_xor(sy, 4);
        const float mean = sy * (1.f / 64.f);
        float sv = 0.f;
#pragma unroll
        for (int i = 0; i < 8; ++i) { const float dd = y[i] - mean; sv += dd * dd; }
        sv += __shfl_xor(sv, 1); sv += __shfl_xor(sv, 2); sv += __shfl_xor(sv, 4);
        const float rs = rsqrtf(sv * (1.f / 64.f) + 64e-5f);
#pragma unroll
        for (int i = 0; i < 8; ++i) za[i] = ((y[i] - mean) * rs * lw[i] + lb[i] + sb * v[i]) * g[i];
        *(u32x4*)(ZA + (size_t)row * 512 + c0) = pack8(za);
    }
}

__device__ void phase_e(const Params& P, int bid, int nb) {
    const int tid = TID(), wid = tid >> 6, lane = tid & 63;
    const bf16_t* MIX = wsb(P, MIX_O); bf16_t* HN = wsbw(P, HN_O); const float* rss = (const float*)(P.ws + ROWSS1);
    for (int rowA = bid * 8 + wid; rowA < MP; rowA += nb * 16) {
        const int rowB = rowA + nb * 8; const bool hasB = rowB < MP; const int rB = hasB ? rowB : rowA;
        const int rows[2] = {rowA, rB};
        f32x4 xv[2][4]; u32x2 mb[2][4]; float rs[2];
#pragma unroll
        for (int q = 0; q < 2; ++q) { rs[q] = rss[rows[q]];
#pragma unroll
            for (int i = 0; i < 4; ++i) { const int c = lane * 4 + 256 * i; xv[q][i] = __builtin_nontemporal_load((const f32x4*)(P.in[I_XP] + (size_t)rows[q] * 1024 + c)); mb[q][i] = __builtin_nontemporal_load((const u32x2*)(MIX + (size_t)rows[q] * 1024 + c)); } }
        f32x4 g1[4], g2[4];
#pragma unroll
        for (int i = 0; i < 4; ++i) { g1[i] = *(const f32x4*)(P.in[I_NPOM] + lane * 4 + 256 * i); g2[i] = *(const f32x4*)(P.in[I_NPF] + lane * 4 + 256 * i); }
        float ss[2];
#pragma unroll
        for (int q = 0; q < 2; ++q) { const float sc = rsqrtf(rs[q] * (1.f / 1024.f) + 1e-6f); ss[q] = 0.f;
#pragma unroll
            for (int i = 0; i < 4; ++i) { const f32x4 m = (f32x4){bflo(mb[q][i].x), bfhi(mb[q][i].x), bflo(mb[q][i].y), bfhi(mb[q][i].y)};
                xv[q][i] = xv[q][i] + m * sc * g1[i];
                ss[q] += xv[q][i].x * xv[q][i].x + xv[q][i].y * xv[q][i].y + xv[q][i].z * xv[q][i].z + xv[q][i].w * xv[q][i].w; } }
        ss[0] = wave_sum(ss[0]); ss[1] = wave_sum(ss[1]);
#pragma unroll
        for (int q = 0; q < 2; ++q) { const float s2 = rsqrtf(ss[q] * (1.f / 1024.f) + 1e-6f);
            if (q == 0 || hasB) {
#pragma unroll
                for (int i = 0; i < 4; ++i) { const f32x4 t = xv[q][i] * s2 * g2[i]; u32x2 w; w.x = pk2(t.x, t.y); w.y = pk2(t.z, t.w); *(u32x2*)(HN + (size_t)rows[q] * 1024 + lane * 4 + 256 * i) = w; } } }
    }
    for (int row = MP + bid * 8 + wid; row < MPAD; row += nb * 8) {
        bf16_t* o = HN + (size_t)row * 1024;
        if (row >= MT) { for (int i = 0; i < 4; ++i) *(u32x2*)(o + lane * 4 + 256 * i) = (u32x2){0u, 0u}; continue; }
        const float* x = row < MP ? P.in[I_XP] + (size_t)row * 1024 : P.in[I_XS] + (size_t)(row - MP) * 1024;
        float* x1o = P.out + (size_t)row * 1024;
        f32x4 mx[4]; float sc;
        if (row < MP) {
#pragma unroll
            for (int i = 0; i < 4; ++i) { const u32x2 mb = *(const u32x2*)(MIX + (size_t)row * 1024 + lane * 4 + 256 * i); mx[i] = (f32x4){bflo(mb.x), bfhi(mb.x), bflo(mb.y), bfhi(mb.y)}; }
            sc = rsqrtf(rss[row] * (1.f / 1024.f) + 1e-6f);
        } else {
            const float* ms = (const float*)(P.ws + MIXS_O) + (size_t)(row - MP) * 1024; float s0 = 0.f;
#pragma unroll
            for (int i = 0; i < 4; ++i) { mx[i] = *(const f32x4*)(ms + lane * 4 + 256 * i); s0 += mx[i].x * mx[i].x + mx[i].y * mx[i].y + mx[i].z * mx[i].z + mx[i].w * mx[i].w; }
            sc = rsqrtf(wave_sum(s0) * (1.f / 1024.f) + 1e-6f);
        }
        f32x4 v[4]; float ss = 0.f;
#pragma unroll
        for (int i = 0; i < 4; ++i) {
            const int c = lane * 4 + 256 * i;
            const f32x4 xv = *(const f32x4*)(x + c), g = *(const f32x4*)(P.in[I_NPOM] + c);
            v[i] = xv + mx[i] * sc * g;
            *(f32x4*)(x1o + c) = v[i];
            ss += v[i].x * v[i].x + v[i].y * v[i].y + v[i].z * v[i].z + v[i].w * v[i].w;
        }
        ss = wave_sum(ss);
        const float s2 = rsqrtf(ss * (1.f / 1024.f) + 1e-6f);
#pragma unroll
        for (int i = 0; i < 4; ++i) { const int c = lane * 4 + 256 * i; const f32x4 g = *(const f32x4*)(P.in[I_NPF] + c);
            u32x2 w; w.x = pk2(v[i].x * s2 * g.x, v[i].y * s2 * g.y); w.y = pk2(v[i].z * s2 * g.z, v[i].w * s2 * g.w); *(u32x2*)(o + c) = w; }
    }
}

__device__ void phase_f2(const Params& P, int bid, int nb) {
    const float* STASH = (const float*)(P.ws + STASH_O);
    bf16_t* ACT = wsbw(P, ACT_O);
    const float* cw = P.in[I_FCW]; const float* cbias = P.in[I_FCB];
    for (int idx = bid * 512 + TID(); idx < 256 * 2 * 704; idx += nb * 512) {
        const int c = (idx % 704) * 4, q = idx / 704, rr = q & 1, g = q >> 1, row = g * 64 + rr;
        const bool first = (g & 31) == 0;
        const float* sc = STASH + (size_t)g * 4 * DFF2; const float* spv = sc - 4 * DFF2;
        f32x4 a;
#pragma unroll
        for (int half = 0; half < 2; ++half) {
            const int cc = c + half * DFF;
            const f32x4 z = (f32x4){0.f, 0.f, 0.f, 0.f};
            f32x4 x0, x1, x2;
            if (rr == 0) { x0 = __builtin_nontemporal_load((const f32x4*)(sc + cc)); x1 = first ? z : __builtin_nontemporal_load((const f32x4*)(spv + 3 * DFF2 + cc)); x2 = first ? z : __builtin_nontemporal_load((const f32x4*)(spv + 2 * DFF2 + cc)); }
            else { x0 = __builtin_nontemporal_load((const f32x4*)(sc + DFF2 + cc)); x1 = __builtin_nontemporal_load((const f32x4*)(sc + cc)); x2 = first ? z : __builtin_nontemporal_load((const f32x4*)(spv + 3 * DFF2 + cc)); }
            const f32x4 w0 = *(const f32x4*)(cw + cc), w1 = *(const f32x4*)(cw + DFF2 + cc), w2 = *(const f32x4*)(cw + 2 * DFF2 + cc), bb = *(const f32x4*)(cbias + cc);
            const f32x4 uu = bb + w0 * x2 + w1 * x1 + w2 * x0;
            if (half == 0) { a.x = gelu_t(uu.x); a.y = gelu_t(uu.y); a.z = gelu_t(uu.z); a.w = gelu_t(uu.w); }
            else a = a * uu;
        }
        u32x2 w; w.x = pk2(a.x, a.y); w.y = pk2(a.z, a.w);
        *(u32x2*)(ACT + (size_t)row * DFF + c) = w;
    }
    { const float* SUP = (const float*)(P.ws + SUP_O);
      for (int idx = bid * 512 + TID(); idx < 256 * 704; idx += nb * 512) {
        const int c = (idx % 704) * 4, b = idx / 704;
        if (b >= 128) { *(u32x2*)(ACT + (size_t)(MP + b) * DFF + c) = (u32x2){0u, 0u}; continue; }
        const float* st = P.in[I_SFCONV] + (size_t)b * 2 * DFF2; float* so = P.out + O_SFCONV + (size_t)b * 2 * DFF2;
        f32x4 a;
#pragma unroll
        for (int half = 0; half < 2; ++half) {
            const int cc = c + half * DFF;
            const f32x4 x0 = *(const f32x4*)(SUP + (size_t)b * DFF2 + cc), x1 = *(const f32x4*)(st + DFF2 + cc), x2 = *(const f32x4*)(st + cc);
            const f32x4 w0 = *(const f32x4*)(cw + cc), w1 = *(const f32x4*)(cw + DFF2 + cc), w2 = *(const f32x4*)(cw + 2 * DFF2 + cc), bb = *(const f32x4*)(cbias + cc);
            const f32x4 uu = bb + w0 * x2 + w1 * x1 + w2 * x0;
            if (half == 0) { a.x = gelu_t(uu.x); a.y = gelu_t(uu.y); a.z = gelu_t(uu.z); a.w = gelu_t(uu.w); }
            else a = a * uu;
            *(f32x4*)(so + cc) = x1; *(f32x4*)(so + DFF2 + cc) = x0;
        }
        u32x2 w; w.x = pk2(a.x, a.y); w.y = pk2(a.z, a.w);
        *(u32x2*)(ACT + (size_t)(MP + b) * DFF + c) = w;
      } }
    for (int idx = bid * 512 + TID(); idx < 8 * 2 * 1408; idx += nb * 512) {
        const int c = (idx % 1408) * 4, q = idx / 1408, j = q & 1, b = q >> 1;
        *(f32x4*)(P.out + O_PFCONV + ((size_t)b * 2 + j) * DFF2 + c) = *(const f32x4*)(STASH + ((size_t)(b * 32 + 31) * 4 + 2 + j) * DFF2 + c);
    }
}

__device__ void phase_h(const Params& P, int bid, int nb) {
    const int tid = TID(), wid = tid >> 6, lane = tid & 63;
    const bf16_t* F = wsb(P, F_O); const float* rss = (const float*)(P.ws + ROWSS2);
    const bf16_t* MIX = wsb(P, MIX_O); const float* rss1 = (const float*)(P.ws + ROWSS1);
    for (int rowA = bid * 8 + wid; rowA < MP; rowA += nb * 16) {
        const int rowB = rowA + nb * 8; const bool hasB = rowB < MP; const int rows[2] = {rowA, hasB ? rowB : rowA};
        f32x4 xv[2][4]; u32x2 fb[2][4], mb[2][4]; float rs[2], rs1[2];
#pragma unroll
        for (int q = 0; q < 2; ++q) { rs[q] = rss[rows[q]]; rs1[q] = rss1[rows[q]];
#pragma unroll
            for (int i = 0; i < 4; ++i) { const int c = lane * 4 + 256 * i; xv[q][i] = __builtin_nontemporal_load((const f32x4*)(P.in[I_XP] + (size_t)rows[q] * 1024 + c));
                fb[q][i] = __builtin_nontemporal_load((const u32x2*)(F + (size_t)rows[q] * 1024 + c)); mb[q][i] = __builtin_nontemporal_load((const u32x2*)(MIX + (size_t)rows[q] * 1024 + c)); } }
#pragma unroll
        for (int q = 0; q < 2; ++q) { const float sc = rsqrtf(rs[q] * (1.f / 1024.f) + 1e-6f), sc1 = rsqrtf(rs1[q] * (1.f / 1024.f) + 1e-6f);
            if (q == 0 || hasB) {
#pragma unroll
                for (int i = 0; i < 4; ++i) { const f32x4 g = *(const f32x4*)(P.in[I_NPOF] + lane * 4 + 256 * i), g1 = *(const f32x4*)(P.in[I_NPOM] + lane * 4 + 256 * i);
                    const f32x4 f = (f32x4){bflo(fb[q][i].x), bfhi(fb[q][i].x), bflo(fb[q][i].y), bfhi(fb[q][i].y)};
                    const f32x4 m = (f32x4){bflo(mb[q][i].x), bfhi(mb[q][i].x), bflo(mb[q][i].y), bfhi(mb[q][i].y)};
                    *(f32x4*)(P.out + (size_t)rows[q] * 1024 + lane * 4 + 256 * i) = (xv[q][i] + m * sc1 * g1) + f * sc * g; } } }
    }
    for (int row = MP + bid * 8 + wid; row < MT; row += nb * 8) {
        float* xo = P.out + (size_t)row * 1024;
        f32x4 fx[4]; float sc;
        if (row < MP) {
#pragma unroll
            for (int i = 0; i < 4; ++i) { const u32x2 fb = *(const u32x2*)(F + (size_t)row * 1024 + lane * 4 + 256 * i); fx[i] = (f32x4){bflo(fb.x), bfhi(fb.x), bflo(fb.y), bfhi(fb.y)}; }
            sc = rsqrtf(rss[row] * (1.f / 1024.f) + 1e-6f);
        } else {
            const float* fs = (const float*)(P.ws + FS_O) + (size_t)(row - MP) * 1024; float s0 = 0.f;
#pragma unroll
            for (int i = 0; i < 4; ++i) { fx[i] = *(const f32x4*)(fs + lane * 4 + 256 * i); s0 += fx[i].x * fx[i].x + fx[i].y * fx[i].y + fx[i].z * fx[i].z + fx[i].w * fx[i].w; }
            sc = rsqrtf(wave_sum(s0) * (1.f / 1024.f) + 1e-6f);
        }
#pragma unroll
        for (int i = 0; i < 4; ++i) {
            const int c = lane * 4 + 256 * i;
            f32x4 xv = *(const f32x4*)(xo + c); const f32x4 g = *(const f32x4*)(P.in[I_NPOF] + c);
            xv = xv + fx[i] * sc * g;
            *(f32x4*)(xo + c) = xv;
        }
    }
}

template <int NST, int NP, class Epi>
__device__ __forceinline__ void sample_gemm(LAS unsigned char* ldsb, int bid, int nb, const bf16_t* A0, const bf16_t* Bt0, const bf16_t* A1, const bf16_t* Bt1, const Epi& epi) {
    constexpr int K = NST * 32 * 8;
    const int tid = TID(), wid = tid >> 6, lane = tid & 63, fr = lane & 15, fq = lane >> 4;
    LAS float* red = (LAS float*)ldsb;
    for (int it = bid; it < 256; it += nb) {
        const int row0 = 32 * (it & 3), col0 = 16 * (it >> 2), kb = wid * (K / 8) + fq * 8;
        f32x4 acc[NP][2];
#pragma unroll
        for (int p = 0; p < NP; ++p) {
            acc[p][0] = (f32x4){0.f, 0.f, 0.f, 0.f}; acc[p][1] = acc[p][0];
            const bf16_t* Ap = (p ? A1 : A0) + (size_t)(MP + row0 + fr) * K + kb;
            const bf16_t* Bp = (p ? Bt1 : Bt0) + (size_t)(col0 + fr) * K + kb;
            bf16x8 a0[NST], a1[NST], bb[NST];
#pragma unroll
            for (int s_ = 0; s_ < NST; ++s_) { a0[s_] = *(const bf16x8*)(Ap + s_ * 32); a1[s_] = *(const bf16x8*)(Ap + (size_t)16 * K + s_ * 32); bb[s_] = *(const bf16x8*)(Bp + s_ * 32); }
#pragma unroll
            for (int s_ = 0; s_ < NST; ++s_) { acc[p][0] = __builtin_amdgcn_mfma_f32_16x16x32_bf16(a0[s_], bb[s_], acc[p][0], 0, 0, 0); acc[p][1] = __builtin_amdgcn_mfma_f32_16x16x32_bf16(a1[s_], bb[s_], acc[p][1], 0, 0, 0); }
        }
#pragma unroll
        for (int p = 0; p < NP; ++p)
#pragma unroll
            for (int t = 0; t < 2; ++t) *(LAS f32x4*)(red + ((((wid * NP + p) * 2 + t) * 64) + lane) * 4) = acc[p][t];
        __syncthreads();
        if (wid < 2) {
            f32x4 r[NP];
#pragma unroll
            for (int p = 0; p < NP; ++p) { r[p] = (f32x4){0.f, 0.f, 0.f, 0.f};
#pragma unroll
                for (int w = 0; w < 8; ++w) r[p] += *(const LAS f32x4*)(red + ((((w * NP + p) * 2 + wid) * 64) + lane) * 4); }
#pragma unroll
            for (int i = 0; i < 4; ++i) epi(r, i, row0 + 16 * wid + fq * 4 + i, col0 + fr);
        }
        __syncthreads();
    }
}

#define XB_TMO      128
#define XB_XCNT(j)  (256  + 64 * (j))
#define XB_XSUB(j)  (1280 + 64 * (j))
#define XB_XGEN(j)  (2304 + 64 * (j))
#define XB_TOP      3328
#define XB_TOPGEN   3392
#define XCD_BAR_WORDS 3456
#define XB_SPIN_CAP (1u << 18)
__device__ __forceinline__ unsigned xb_ld(unsigned* p)              { return __hip_atomic_load(p, __ATOMIC_RELAXED, __HIP_MEMORY_SCOPE_AGENT); }
__device__ __forceinline__ unsigned xb_add(unsigned* p, unsigned v) { return __hip_atomic_fetch_add(p, v, __ATOMIC_RELAXED, __HIP_MEMORY_SCOPE_AGENT); }
__device__ __forceinline__ unsigned xb_xcc_id() { return (unsigned)__builtin_amdgcn_s_getreg((3 << 11) | 20) & 0xFu; }
#define XB_SPIN(cond, bar) do { unsigned _sp = 0; while (cond) { __builtin_amdgcn_s_sleep(1); \
    if ((++_sp & 255u) == 0u) { if (xb_ld(&(bar)[XB_TMO])) break; if (_sp > XB_SPIN_CAP) { atomicAdd(&(bar)[XB_TMO], 1u); break; } } } } while (0)
struct XcdBarrier { unsigned* bar; unsigned x; volatile LAS unsigned* st; };
__device__ __forceinline__ XcdBarrier xcd_barrier_post(unsigned* bar, volatile LAS unsigned* st) {
    XcdBarrier b; b.bar = bar; b.x = xb_xcc_id(); b.st = st;
    if (threadIdx.x == 0) (void)xb_add(&bar[XB_XCNT(b.x)], 1u);
    return b;
}
__device__ __forceinline__ void xcd_barrier_complete(unsigned* bar, unsigned x, unsigned& nloc, unsigned& nx) {
    const unsigned G = gridDim.x * gridDim.y * gridDim.z;
    unsigned sum, cnt, mine, sp = 0u;
    for (;;) {
        sum = 0u; cnt = 0u; mine = 0u;
#pragma unroll
        for (unsigned j = 0; j < 16; ++j) { const unsigned c = xb_ld(&bar[XB_XCNT(j)]); sum += c; cnt += (c > 0u) ? 1u : 0u; mine = (j == x) ? c : mine; }
        if (sum == G) break;
        __builtin_amdgcn_s_sleep(1);
        if ((++sp & 255u) == 0u) { if (xb_ld(&bar[XB_TMO])) break; if (sp > XB_SPIN_CAP) { atomicAdd(&bar[XB_TMO], 1u); break; } }
    }
    nloc = mine > 0u ? mine : 1u; nx = cnt > 0u ? cnt : 1u;
}
__device__ __forceinline__ void xcd_barrier(const XcdBarrier& b) {
    asm volatile("s_waitcnt vmcnt(0)" ::: "memory");
    __syncthreads();
    if (TID() == 0) {
        unsigned* bar = b.bar;
        __builtin_amdgcn_s_waitcnt(0);
        unsigned nloc = b.st[0], nx = b.st[1];
        if (nloc == 0u) { xcd_barrier_complete(bar, b.x, nloc, nx); b.st[0] = nloc; b.st[1] = nx; }
        const unsigned old = xb_add(&bar[XB_XSUB(b.x)], 1u);
        const unsigned gen = old / nloc;
        if (old + 1u == (gen + 1u) * nloc) {
            __builtin_amdgcn_fence(__ATOMIC_RELEASE, "agent");
            asm volatile("s_waitcnt vmcnt(0)" ::: "memory");
            const unsigned og = xb_add(&bar[XB_TOP], 1u);
            const unsigned tg = og / nx;
            if (og + 1u == (tg + 1u) * nx) xb_add(&bar[XB_TOPGEN], 1u);
            else XB_SPIN(xb_ld(&bar[XB_TOPGEN]) == tg, bar);
            __builtin_amdgcn_fence(__ATOMIC_ACQUIRE, "agent");
            xb_add(&bar[XB_XGEN(b.x)], 1u);
            asm volatile("s_waitcnt vmcnt(0)" ::: "memory");
        } else {
            XB_SPIN(xb_ld(&bar[XB_XGEN(b.x)]) == gen, bar);
            __builtin_amdgcn_fence(__ATOMIC_ACQUIRE, "agent");
            asm volatile("s_waitcnt vmcnt(0)" ::: "memory");
        }
    }
    __syncthreads();
}

constexpr int NPHASE = 13;
__device__ __forceinline__ void run_phase(const Params& P, const int ph, LAS unsigned char* lds, int bid, int nb) {
    asm volatile("" : "+s"(bid), "+s"(nb));
    Sched S;
#ifdef PROBE_TS
#define TSACC(S_) (S_).tsacc = (unsigned long long*)(P.ws + TS_O) + 48 + ph
#else
#define TSACC(S_) do { } while (0)
#endif
    switch (ph) {
    case 0: phase0(P, lds, bid, nb); break;
    case 1: { S.init(P.ws + XN_O, P.ws + W_IN_T, nullptr, nullptr, MPAD, INC, 1024, nb, bid, 0); TSACC(S); EpiStore E{wsbw(P, PROJ_O), INC, nullptr}; gemm_phase(lds, S, 1024, E); } break;
    case 2: phase_b0(P, bid, nb); break;
    case 3: { S.init((unsigned char*)P.out + LA_O, P.ws + W_LORA_T, nullptr, nullptr, MPAD, 1536, 256, nb, bid, 0); TSACC(S); EpiLora E{&P}; gemm_phase(lds, S, 256, E);
              S.init((unsigned char*)P.out + XC_O, P.ws + W_LRUG_T, nullptr, nullptr, MPAD, 1024, 512, nb, (bid + nb / 2 - 8) % nb, 0); TSACC(S); EpiLru E2{&P}; gemm_phase(lds, S, 512, E2); } break;
    case 4: if (nb == 256) { wkv_scan<true>(P, bid, (LAS float*)lds, bid, nb); __syncthreads(); }
            else { const int t_ = TID(); sample_wkv(P, bid * 8 + (t_ >> 6), nb * 8); sample_lru(P, bid * 512 + t_, nb * 512); lru_pass1(P, bid * 512 + t_, nb * 512);
                   for (int it = bid; it < 256; it += nb) { wkv_scan<false>(P, it, (LAS float*)lds, bid, nb); __syncthreads(); } }
            break;
    case 5: lru_pass2(P, bid, nb); phase_za(P, bid, nb); break;
    case 6: { { const bf16_t* proj = wsb(P, PROJ_O); bf16_t* O = wsbw(P, MIXIN_O);
                auto epi = [&](const f32x4 (&r)[2], int i, int row, int col) { const bf16_t* gp = proj + (size_t)(MP + row) * INC + 2304 + col;
                    O[(size_t)(MP + row) * 1024 + col] = f2bf(sigm(bf1(gp[0])) * r[0][i] + sigm(bf1(gp[1024])) * r[1][i]); };
                sample_gemm<2, 2>(lds, bid, nb, outb(P, ZA_O), wsb(P, W_A_T), outb(P, HS_O), wsb(P, W_B_T), epi); }
              S.init((unsigned char*)P.out + ZA_O, P.ws + W_A_T, (unsigned char*)P.out + HS_O, P.ws + W_B_T, MP, 1024, 512, nb, bid, 1); TSACC(S); EpiMix E{&P}; gemm_phase(lds, S, 512, E); } break;
    case 7: { { float* O = (float*)(P.ws + MIXS_O); auto epi = [&](const f32x4 (&r)[1], int i, int row, int col) { O[(size_t)row * 1024 + col] = r[0][i]; };
                sample_gemm<4, 1>(lds, bid, nb, wsb(P, MIXIN_O), wsb(P, W_O_T), nullptr, nullptr, epi); }
              S.init(P.ws + MIXIN_O, P.ws + W_O_T, nullptr, nullptr, MP, 1024, 1024, nb, bid, 0); TSACC(S); EpiStore E{wsbw(P, MIX_O), 1024, (float*)(P.ws + ROWSS1)}; gemm_phase(lds, S, 1024, E); } break;
    case 8: phase_e(P, bid, nb); break;
    case 9: { S.init(P.ws + HN_O, P.ws + W_UP_T, nullptr, nullptr, MPAD, DFF2, 1024, nb, bid, 0); TSACC(S); EpiUp E{&P}; gemm_phase(lds, S, 1024, E); } break;
    case 10: phase_f2(P, bid, nb); break;
    case 11: { { float* O = (float*)(P.ws + FS_O); auto epi = [&](const f32x4 (&r)[1], int i, int row, int col) { O[(size_t)row * 1024 + col] = r[0][i]; };
                 sample_gemm<11, 1>(lds, bid, nb, wsb(P, ACT_O), wsb(P, W_DN_T), nullptr, nullptr, epi); }
               S.init(P.ws + ACT_O, P.ws + W_DN_T, nullptr, nullptr, MP, 1024, DFF, nb, bid, 0); TSACC(S); EpiStore E{wsbw(P, F_O), 1024, (float*)(P.ws + ROWSS2)}; gemm_phase(lds, S, DFF, E); } break;
    case 12: phase_h(P, bid, nb); break;
    }
}

template <int PH0, int PH1>
__global__ void __launch_bounds__(512, 2) mega(Params P) {
    extern __shared__ __attribute__((aligned(16))) unsigned char shm[];
    LAS unsigned char* lds = (LAS unsigned char*)shm;
    cg::grid_group grid = cg::this_grid();
    volatile LAS unsigned* xbst = (volatile LAS unsigned*)(lds + 131072);
    if (threadIdx.x == 0) { xbst[0] = 0u; xbst[1] = 0u; }
    __syncthreads();
    const XcdBarrier xb = xcd_barrier_post((unsigned*)(P.ws + BAR_O), xbst);
    if (gridDim.y == 0x7fffffffu) grid.sync();
#define MK_PHASE(ph) do { if constexpr ((ph) >= PH0 && (ph) < PH1) { \
          \
        const __attribute__((address_space(4))) Params* kp = (const __attribute__((address_space(4))) Params*)__builtin_amdgcn_kernarg_segment_ptr(); \
        asm volatile("" : "+s"(kp)); \
        if ((ph) == 0) { if (blockIdx.x == 0 && threadIdx.x < 64) ((unsigned long long*)(kp->ws + TS_O))[threadIdx.x] = 0ull; __syncthreads(); MARK(*kp, 0); } \
        run_phase(*(const Params*)kp, (ph), lds, blockIdx.x, gridDim.x); MARK(*kp, 2 * (ph) + 1); \
        if constexpr ((ph) + 1 < PH1) { xcd_barrier(xb); MARK(*kp, 2 * (ph) + 2); } } } while (0)
#ifdef DUP_PHASE
#define MK_DUP(ph) do { if constexpr ((ph) == DUP_PHASE) { const __attribute__((address_space(4))) Params* kp = (const __attribute__((address_space(4))) Params*)__builtin_amdgcn_kernarg_segment_ptr(); \
        asm volatile("" : "+s"(kp)); run_phase(*(const Params*)kp, (ph), lds, blockIdx.x, gridDim.x); grid.sync(); } } while (0)
#else
#define MK_DUP(ph) do { } while (0)
#endif
    MK_DUP(0); MK_PHASE(0); MK_DUP(1); MK_PHASE(1); MK_DUP(2); MK_PHASE(2); MK_DUP(3); MK_PHASE(3); MK_DUP(4); MK_PHASE(4); MK_PHASE(5); MK_DUP(6); MK_PHASE(6);
    MK_PHASE(7); MK_DUP(8); MK_PHASE(8); MK_DUP(9); MK_PHASE(9); MK_DUP(10); MK_PHASE(10); MK_PHASE(11); MK_PHASE(12);
#undef MK_PHASE
#ifdef PROBE_TS
    if (blockIdx.x == 0 && threadIdx.x == 0) {
        const unsigned long long* ts = (const unsigned long long*)(P.ws + TS_O);
        auto val = [&](int a, int b) -> unsigned long long { unsigned long long v = (a >= 48) ? ts[a] : ts[b] - ts[a]; v /= (unsigned long long)PQ; return v > 63ull ? 63ull : v; };
        const unsigned long long w = 2000ull * val(PSEL1A, PSEL1B) + 128000ull * val(PSEL2A, PSEL2B);
        const unsigned long long t0 = __builtin_amdgcn_s_memrealtime();
        while (__builtin_amdgcn_s_memrealtime() - t0 < w) __builtin_amdgcn_s_sleep(8);
    }
#endif
}

template <int PH0, int PH1>
static void launch_range(const Params& p, hipStream_t stream) {
    static int grid_blocks = 0;
    const void* fn = (const void*)mega<PH0, PH1>;
    if (!grid_blocks) {
        (void)hipFuncSetAttribute(fn, hipFuncAttributeMaxDynamicSharedMemorySize, LDS_BYTES);
        int dev = 0, cus = 0, per_cu = 0;
        (void)hipGetDevice(&dev);
        (void)hipDeviceGetAttribute(&cus, hipDeviceAttributeMultiprocessorCount, dev);
        (void)hipOccupancyMaxActiveBlocksPerMultiprocessor(&per_cu, mega<PH0, PH1>, 512, LDS_BYTES);
        if (per_cu != 1) fprintf(stderr, "note: occupancy query says %d blocks/CU; using 1\n", per_cu);
        grid_blocks = cus;
        if (per_cu < 1) grid_blocks = 0;
    }
    if (!grid_blocks) { fprintf(stderr, "kernel not launchable\n"); return; }
    Params pl = p;
    void* args[] = {&pl};
    hipError_t e = hipLaunchCooperativeKernel(fn, dim3(grid_blocks), dim3(512), args, LDS_BYTES, stream);
    if (e != hipSuccess) fprintf(stderr, "cooperative launch failed: %s (grid %d)\n", hipGetErrorString(e), grid_blocks);
}

extern "C" void kernel_launch(void* const* d_in, const int* in_sizes, int n_in, void* d_out, int out_size, void* d_ws, size_t ws_size, hipStream_t stream) {
    if (ws_size < WS_NEED) { fprintf(stderr, "workspace too small: %zu < %zu\n", ws_size, (size_t)WS_NEED); return; }
    Params p{};
    for (int i = 0; i < 37; ++i) p.in[i] = (const float*)d_in[i];
    p.out = (float*)d_out; p.ws = (unsigned char*)d_ws;
    (void)hipMemsetAsync((unsigned char*)d_ws + BAR_O, 0, XCD_BAR_WORDS * sizeof(unsigned), stream);
#if ONE_LAUNCH
    launch_range<0, NPHASE>(p, stream);
#else
    launch_range<0, 1>(p, stream); launch_range<1, 2>(p, stream); launch_range<2, 3>(p, stream); launch_range<3, 4>(p, stream);
    launch_range<4, 5>(p, stream); launch_range<5, 6>(p, stream); launch_range<6, 7>(p, stream); launch_range<7, 8>(p, stream);
    launch_range<8, 9>(p, stream); launch_range<9, 10>(p, stream); launch_range<10, 11>(p, stream); launch_range<11, 12>(p, stream);
    launch_range<12, 13>(p, stream);
#endif
}
```
